# Optimizing an MI355X kernel written in HIP

```python
import jax, jax.numpy as jnp
from jax import lax
import numpy as np

D_MODEL = 1024
BATCH = 8
SEQ = 2048
DEPTH = 1
DEC_BATCH = 128
DEC_SEQ = 8
PAST_LEN = 16384
PAGE_SIZE = 128

POOL_WIDTH = D_MODEL // 2
POOL_GROUPS = 4
POOL_GROUP_DIM = POOL_WIDTH // POOL_GROUPS
POOL_WINDOWS = (2, 4, 8, 16)
POOL_BUF = 16 - 1
HGRN_WIDTH = D_MODEL // 2
HGRN_EXPAND = 128
HGRN_HEADS = HGRN_WIDTH // HGRN_EXPAND
HGRN_DK = HGRN_EXPAND
HGRN_DV = HGRN_WIDTH // HGRN_HEADS
CHUNK = 16
D_FF = -(-8 * D_MODEL // (3 * 256)) * 256
P_DIM = 256
EPS = 1e-6
IN_WIDTH = POOL_WIDTH + 4 * HGRN_WIDTH + 2 * D_MODEL

kernel_name = 'pool_hgrn2_gated_hybrid_step'


def rms_norm(x, gain):
    xf = x.astype(jnp.float32)
    y = xf * lax.rsqrt(jnp.mean(xf * xf, axis=-1, keepdims=True) + EPS)
    return (y * gain.astype(jnp.float32)).astype(x.dtype)


def multiscale_pool(u):
    B, T, C = u.shape
    cs = jnp.concatenate([jnp.zeros((B, 1, C), u.dtype), jnp.cumsum(u, axis=1)], axis=1)
    idx = jnp.arange(T)
    means = []
    for g, w in enumerate(POOL_WINDOWS):
        c0 = g * POOL_GROUP_DIM
        csg = cs[:, :, c0:c0 + POOL_GROUP_DIM]
        lo = jnp.maximum(idx + 1 - w, 0)
        cnt = jnp.minimum(idx + 1, w).astype(u.dtype)
        means.append((csg[:, idx + 1] - csg[:, lo]) / cnt[None, :, None])
    return jnp.concatenate(means, axis=-1) - u


def hgrn2_recurrence(q, k, v, logf, s0):
    B, T, H, _ = q.shape
    pad = (-T) % CHUNK
    if pad:
        pw = ((0, 0), (0, pad), (0, 0), (0, 0))
        q, k, v, logf = [jnp.pad(a, pw) for a in (q, k, v, logf)]
    n = (T + pad) // CHUNK

    def blocks(a):
        return a.reshape(B, n, CHUNK, H, a.shape[-1])

    q, k, v, logf = blocks(q), blocks(k), blocks(v), blocks(logf)
    G = jnp.cumsum(logf, axis=2)
    G_last = G[:, :, -1:]
    qe = q * jnp.exp(G)
    ke = k * jnp.exp(-G)
    kd = k * jnp.exp(G_last - G)
    causal = jnp.tril(jnp.ones((CHUNK, CHUNK), dtype=bool))
    A = jnp.einsum('bnthk,bnshk->bnhts', qe, ke)
    A = jnp.where(causal, A, 0.0)
    o_intra = jnp.einsum('bnhts,bnshv->bnthv', A, v)
    dS = jnp.einsum('bnshk,bnshv->bnhkv', kd, v)
    decay = jnp.exp(G_last[:, :, 0])

    def step(S, inp):
        qe_c, dec_c, dS_c = inp
        o_c = jnp.einsum('bthk,bhkv->bthv', qe_c, S)
        return dec_c[..., None] * S + dS_c, o_c

    S, o_inter = lax.scan(step, s0, (jnp.moveaxis(qe, 1, 0), jnp.moveaxis(decay, 1, 0), jnp.moveaxis(dS, 1, 0)))
    o = o_intra + jnp.moveaxis(o_inter, 0, 1)
    o = o.reshape(B, n * CHUNK, H, HGRN_DV)[:, :T]
    return o, S


def run_trunk(x, p, state_pool, state_hgrn, w):
    f32 = jnp.float32
    B, T, _ = x.shape
    dt = x.dtype
    out_dt = dt if state_pool is None else state_pool.dtype
    splits = [POOL_WIDTH, POOL_WIDTH + HGRN_WIDTH, POOL_WIDTH + 2 * HGRN_WIDTH,
              POOL_WIDTH + 3 * HGRN_WIDTH, POOL_WIDTH + 4 * HGRN_WIDTH,
              POOL_WIDTH + 4 * HGRN_WIDTH + D_MODEL]
    lb_all = jnp.cumsum(jax.nn.softmax(w['hgrn_lb'].astype(f32), axis=0), axis=0)
    new_pool, new_hgrn = [], []
    for l in range(DEPTH):
        h = rms_norm(x, w['g_mix'][l])
        z = (h @ w['w_in'][l]).astype(f32)
        u, zq, zf, zi, zg, ga, gb = jnp.split(z, splits, axis=-1)

        u_ext = u if state_pool is None else jnp.concatenate([state_pool[l].astype(f32), u], axis=1)
        new_pool.append(u_ext[:, -POOL_BUF:].astype(out_dt))
        pooled = multiscale_pool(u_ext)[:, -T:].reshape(B, T, POOL_GROUPS, POOL_GROUP_DIM)
        pool_out = jnp.einsum('btgc,gcd->btgd', pooled, w['w_pool_mix'][l].astype(f32))
        pool_out = pool_out.reshape(B, T, POOL_WIDTH) * w['pool_scale'][l].astype(f32)

        lb = lb_all[l]
        fg = lb + (1.0 - lb) * jax.nn.sigmoid(zf)
        heads = lambda a: a.reshape(B, T, HGRN_HEADS, -1)
        q = heads(jax.nn.silu(zq))
        k = heads(1.0 - fg)
        logf = heads(jnp.log(fg))
        v = heads(zi)
        s0 = jnp.zeros((B, HGRN_HEADS, HGRN_DK, HGRN_DV), f32) if state_hgrn is None else state_hgrn[l].astype(f32)
        o, s_new = hgrn2_recurrence(q, k, v, logf, s0)
        new_hgrn.append(s_new.astype(out_dt))
        o = o * lax.rsqrt(jnp.mean(o * o, axis=-1, keepdims=True) + EPS)
        o = o * w['hgrn_norm'][l].astype(f32).reshape(HGRN_HEADS, HGRN_DV)
        o = o.reshape(B, T, HGRN_WIDTH) * jax.nn.silu(zg)

        ya = pool_out.astype(dt) @ w['w_pool_up'][l]
        yb = o.astype(dt) @ w['w_hgrn_up'][l]
        merged = (jax.nn.sigmoid(ga) * ya.astype(f32) + jax.nn.sigmoid(gb) * yb.astype(f32)).astype(dt)
        x = x + merged @ w['w_out'][l]

        h2 = rms_norm(x, w['g_ffn'][l])
        x = x + (jax.nn.silu(h2 @ w['w_ffn_gate'][l]) * (h2 @ w['w_ffn_up'][l])) @ w['w_ffn_down'][l]

        h3 = rms_norm(x, w['g_ple'][l])
        gate = jax.nn.sigmoid((h3 @ w['w_ple_gate'][l]).astype(f32))
        emb = (p[l].astype(dt) @ w['w_ple_proj'][l]).astype(f32)
        x = x + (gate * emb).astype(dt)

    y = rms_norm(x, w['g_final'])
    return y, jnp.stack(new_pool, axis=0), jnp.stack(new_hgrn, axis=0)


def setup_inputs(seed: int = 0) -> dict:
    key = jax.random.key(seed)
    ks = jax.random.split(key, 24)
    f32 = jnp.float32

    def nrm(k, shape, scale):
        return jax.random.normal(k, shape, f32) * scale

    def gain(k, shape):
        return 1.0 + 0.05 * jax.random.normal(k, shape, f32)

    return {
        'x_prompt': nrm(ks[0], (BATCH, SEQ, D_MODEL), 1.0),
        'x_sample': nrm(ks[1], (DEC_BATCH, DEC_SEQ, D_MODEL), 1.0),
        'state_pool': nrm(ks[2], (DEPTH, DEC_BATCH, POOL_BUF, POOL_WIDTH), 1.0),
        'state_hgrn': nrm(ks[3], (DEPTH, DEC_BATCH, HGRN_HEADS, HGRN_DK, HGRN_DV), 0.5),
        'p_prompt': nrm(ks[4], (DEPTH, BATCH, SEQ, P_DIM), 1.0),
        'p_sample': nrm(ks[5], (DEPTH, DEC_BATCH, DEC_SEQ, P_DIM), 1.0),
        'g_mix': gain(ks[6], (DEPTH, D_MODEL)),
        'w_in': nrm(ks[7], (DEPTH, D_MODEL, IN_WIDTH), D_MODEL ** -0.5),
        'w_pool_mix': nrm(ks[8], (DEPTH, POOL_GROUPS, POOL_GROUP_DIM, POOL_GROUP_DIM), POOL_GROUP_DIM ** -0.5),
        'pool_scale': gain(ks[9], (DEPTH, POOL_WIDTH)),
        'hgrn_lb': nrm(ks[10], (DEPTH + 1, HGRN_WIDTH), 0.1),
        'hgrn_norm': gain(ks[11], (DEPTH, HGRN_WIDTH)),
        'w_pool_up': nrm(ks[12], (DEPTH, POOL_WIDTH, D_MODEL), POOL_WIDTH ** -0.5),
        'w_hgrn_up': nrm(ks[13], (DEPTH, HGRN_WIDTH, D_MODEL), HGRN_WIDTH ** -0.5),
        'w_out': nrm(ks[14], (DEPTH, D_MODEL, D_MODEL), D_MODEL ** -0.5),
        'g_ffn': gain(ks[15], (DEPTH, D_MODEL)),
        'w_ffn_gate': nrm(ks[16], (DEPTH, D_MODEL, D_FF), D_MODEL ** -0.5),
        'w_ffn_up': nrm(ks[17], (DEPTH, D_MODEL, D_FF), D_MODEL ** -0.5),
        'w_ffn_down': nrm(ks[18], (DEPTH, D_FF, D_MODEL), D_FF ** -0.5),
        'g_ple': gain(ks[19], (DEPTH, D_MODEL)),
        'w_ple_gate': nrm(ks[20], (DEPTH, D_MODEL, D_MODEL), D_MODEL ** -0.5),
        'w_ple_proj': nrm(ks[21], (DEPTH, P_DIM, D_MODEL), P_DIM ** -0.5),
        'g_final': gain(ks[22], (D_MODEL,)),
    }


def reference(x_prompt, x_sample, state_pool, state_hgrn, p_prompt, p_sample,
              g_mix, w_in, w_pool_mix, pool_scale, hgrn_lb, hgrn_norm,
              w_pool_up, w_hgrn_up, w_out, g_ffn, w_ffn_gate, w_ffn_up, w_ffn_down,
              g_ple, w_ple_gate, w_ple_proj, g_final):
    w = {
        'g_mix': g_mix, 'w_in': w_in, 'w_pool_mix': w_pool_mix, 'pool_scale': pool_scale,
        'hgrn_lb': hgrn_lb, 'hgrn_norm': hgrn_norm, 'w_pool_up': w_pool_up,
        'w_hgrn_up': w_hgrn_up, 'w_out': w_out, 'g_ffn': g_ffn, 'w_ffn_gate': w_ffn_gate,
        'w_ffn_up': w_ffn_up, 'w_ffn_down': w_ffn_down, 'g_ple': g_ple,
        'w_ple_gate': w_ple_gate, 'w_ple_proj': w_ple_proj, 'g_final': g_final,
    }
    y_prompt, new_pool_prompt, new_hgrn_prompt = run_trunk(x_prompt, p_prompt, None, None, w)
    y_sample, new_pool_sample, new_hgrn_sample = run_trunk(x_sample, p_sample, state_pool, state_hgrn, w)
    return (y_prompt, y_sample, new_pool_prompt, new_hgrn_prompt, new_pool_sample, new_hgrn_sample)
```

```cpp
#include <hip/hip_runtime.h>
#include <hip/hip_cooperative_groups.h>
#include <cstdio>
#include <cstdint>
namespace cg = cooperative_groups;

constexpr int D = 1024, SEQ = 2048, NB = 8, DB = 128, DS = 8;
constexpr int MP = NB * SEQ;
constexpr int MS = DB * DS;
constexpr int M = MP + MS;
constexpr int PW = 512, HW = 512, NH = 4, DK = 128, DV = 128, PBUF = 15;
constexpr int FF = 2816, PD = 256, NIN = 4608;
constexpr float EPS = 1e-6f;

namespace pg8 {
#define PG8_LAS __attribute__((address_space(3)))
typedef unsigned short bf16_t;
typedef short bf16x8 __attribute__((ext_vector_type(8)));
typedef float f32x4 __attribute__((ext_vector_type(4)));
typedef float f32x2 __attribute__((ext_vector_type(2)));
typedef unsigned u32x4 __attribute__((ext_vector_type(4)));
typedef unsigned u32x2 __attribute__((ext_vector_type(2)));
constexpr int BM = 256, BK = 64, HALF = 128, HTB = HALF * BK * 2  , STAGE_BYTES = 8 * HTB, NXCD = 8, WGM = 8;

__host__ __device__ __forceinline__ int lds_byte(int r, int c) { const int st = (r >> 4) * 2 + (c >> 5), rr = r & 15, cc = c & 31, ob = rr * 64 + cc * 2; return st * 1024 + (ob ^ (((ob >> 9) & 1) << 5)); }
__host__ __device__ __forceinline__ void stage_rc(int b, int& R, int& C) { const int st = b / 1024, sb = b % 1024, swz = sb ^ (((sb >> 9) & 1) << 5); R = (st >> 1) * 16 + swz / 64; C = (st & 1) * 32 + (swz % 64) / 2; }
__host__ __device__ __forceinline__ int perm32(int rho) { const int n = rho >> 4, i = rho & 15; return 8 * (i >> 2) + 4 * n + (i & 3); }

struct Unit { int pm, pn; };
struct Gemm { const bf16_t* A; const bf16_t* Bt; int M, N, K, lda, ldb; };

struct StaticOrder {
    int nM, nN, nwg, G, c;
    __host__ __device__ void init(int M_, int N_, int G_, int c_) { nM = M_ / BM; nN = N_ / BM; nwg = nM * nN; G = G_; c = c_; }
    __host__ __device__ bool next(int i, Unit& u) const {
        const long L = (long)i * G + c; if (L >= nwg) return false;
        int wgid = (int)L; { const int q = nwg / NXCD, r = nwg % NXCD, xcd = wgid % NXCD, off = wgid / NXCD; wgid = (xcd < r ? xcd * (q + 1) : r * (q + 1) + (xcd - r) * q) + off; }
        const int nig = WGM * nN, gid = wgid / nig, fm = gid * WGM, gsz = (nM - fm) < WGM ? (nM - fm) : WGM;
        u.pm = fm + ((wgid % nig) % gsz); u.pn = (wgid % nig) / gsz; return true;
    }
    __device__ __forceinline__ void a_ready(const Unit&) const {}
    __device__ __forceinline__ void done(const Unit&) const {}
};

__device__ __forceinline__ unsigned cvt_pk_bf16(float lo, float hi) { unsigned r; asm volatile("v_cvt_pk_bf16_f32 %0, %1, %2" : "=v"(r) : "v"(lo), "v"(hi)); return r; }

template <class Epi, class Sched, bool ALIGN_EPI>
__device__ __forceinline__ void gemm_phase(PG8_LAS unsigned char* lds, const Gemm g, const Sched& S, const Epi& E) {
    const int tid = threadIdx.x, wid = __builtin_amdgcn_readfirstlane(tid >> 6), lane = tid & 63, wr = wid >> 2, wc = wid & 3, fr = lane & 15, fq = lane >> 4;
    int nt = g.K / BK; asm volatile("" : "+s"(nt));
    unsigned voffA[2], voffB[2];
#pragma unroll
    for (int i = 0; i < 2; ++i) { int R, C; stage_rc(tid * 16 + i * 8192, R, C); const int Rb = Epi::PERM ? ((R & ~31) + perm32(R & 31)) : R;
        voffA[i] = (unsigned)(R * g.lda + C) * 2u; voffB[i] = (unsigned)(Rb * g.ldb + C) * 2u; }
    const size_t kstep = (size_t)(BK * 2);
    const size_t hstepA = (size_t)HALF * g.lda * 2, hstepB = (size_t)HALF * g.ldb * 2;
    const size_t tstepA = 2 * hstepA, tstepB = 2 * hstepB;
    const unsigned ldsw = (unsigned)wid * 1024u;
    const int aoff = lds_byte(wr * 64 + fr, fq * 8), boff = lds_byte(wc * 32 + fr, fq * 8);
#define PG8_SA(b, h) (((b) * 2 + (h)) * HTB)
#define PG8_SB(b, h) ((4 + (b) * 2 + (h)) * HTB)
#define PG8_STAGE(bufoff, gbase, voff) do { _Pragma("unroll") for (int _i = 0; _i < 2; ++_i) \
        __builtin_amdgcn_global_load_lds((const unsigned*)((const char*)(gbase) + (voff)[_i]), (PG8_LAS unsigned*)(lds + (bufoff) + ldsw + _i * 8192), 16, 0, 0); } while (0)
#define PG8_LDA(dst, b, h) do { _Pragma("unroll") for (int m = 0; m < 4; ++m) _Pragma("unroll") for (int k = 0; k < 2; ++k) dst[m][k] = *(const PG8_LAS bf16x8*)(lds + PG8_SA(b, h) + aoff + m * 2048 + k * 1024); } while (0)
#define PG8_LDB(dst, b, h) do { _Pragma("unroll") for (int n = 0; n < 2; ++n) _Pragma("unroll") for (int k = 0; k < 2; ++k) dst[n][k] = *(const PG8_LAS bf16x8*)(lds + PG8_SB(b, h) + boff + n * 2048 + k * 1024); } while (0)
#define PG8_MMA(ai, bj, At, Bt) do { __builtin_amdgcn_s_setprio(1); _Pragma("unroll") for (int m = 0; m < 4; ++m) _Pragma("unroll") for (int n = 0; n < 2; ++n) _Pragma("unroll") for (int k = 0; k < 2; ++k) \
        acc[ai][bj][m][n] = __builtin_amdgcn_mfma_f32_16x16x32_bf16(Bt[n][k], At[m][k], acc[ai][bj][m][n], 0, 0, 0); __builtin_amdgcn_s_setprio(0); } while (0)
#define PG8_WAIT_V(n) asm volatile("s_waitcnt vmcnt(" #n ")" ::: "memory")
#define PG8_WAIT_L(n) asm volatile("s_waitcnt lgkmcnt(" #n ")" ::: "memory")
#define PG8_BAR __builtin_amdgcn_s_barrier()
#define PG8_SCHED __builtin_amdgcn_sched_barrier(0)
    Unit cur, nxt; int ui = 0;
    if (!S.next(0, cur)) return;
    f32x4 acc[2][2][4][2];
#pragma unroll
    for (int a = 0; a < 2; ++a)
#pragma unroll
        for (int b = 0; b < 2; ++b)
#pragma unroll
            for (int m = 0; m < 4; ++m)
#pragma unroll
                for (int n = 0; n < 2; ++n) acc[a][b][m][n] = (f32x4){0.f, 0.f, 0.f, 0.f};
    bf16x8 At[4][2], B0[2][2], B1[2][2];
    const char* cA = (const char*)g.A + (size_t)cur.pm * tstepA; const char* cB = (const char*)g.Bt + (size_t)cur.pn * tstepB;
    S.a_ready(cur);
    PG8_STAGE(PG8_SB(0, 0), cB, voffB); PG8_STAGE(PG8_SB(0, 1), cB + hstepB, voffB); PG8_STAGE(PG8_SA(0, 0), cA, voffA); PG8_STAGE(PG8_SA(0, 1), cA + hstepA, voffA);
    if (wr == 1) PG8_BAR;
    PG8_WAIT_V(2); PG8_BAR;
    PG8_STAGE(PG8_SB(1, 0), cB + kstep, voffB); PG8_STAGE(PG8_SA(1, 0), cA + kstep, voffA); PG8_STAGE(PG8_SB(1, 1), cB + hstepB + kstep, voffB);
    PG8_WAIT_V(6); PG8_BAR;
    for (;;) {
        const bool has_next = S.next(ui + 1, nxt);
        const char* nA = has_next ? (const char*)g.A + (size_t)nxt.pm * tstepA : cA; const char* nB = has_next ? (const char*)g.Bt + (size_t)nxt.pn * tstepB : cB;
        for (int t = 0; t < nt; t += 2) {
            const bool last = (t == nt - 2);
            const char* a1 = cA + (size_t)(t + 1) * kstep;
            const char* a2 = last ? nA : cA + (size_t)(t + 2) * kstep; const char* b2 = last ? nB : cB + (size_t)(t + 2) * kstep;
            const char* a3 = a2 + kstep; const char* b3 = b2 + kstep;
            if (last && has_next) S.a_ready(nxt);
            PG8_LDB(B0, 0, 0); PG8_LDB(B1, 0, 1); PG8_SCHED; PG8_LDA(At, 0, 0); PG8_STAGE(PG8_SA(1, 1), a1 + hstepA, voffA);
            PG8_WAIT_V(8); PG8_WAIT_L(0); PG8_BAR; PG8_MMA(0, 0, At, B0); PG8_MMA(0, 1, At, B1); PG8_BAR; PG8_SCHED;
            PG8_LDA(At, 0, 1); PG8_STAGE(PG8_SB(0, 0), b2, voffB); PG8_STAGE(PG8_SB(0, 1), b2 + hstepB, voffB); PG8_STAGE(PG8_SA(0, 0), a2, voffA);
            PG8_WAIT_V(8); PG8_WAIT_L(0); PG8_BAR; PG8_MMA(1, 0, At, B0); PG8_MMA(1, 1, At, B1); PG8_BAR; PG8_SCHED;
            PG8_LDB(B0, 1, 0); PG8_LDB(B1, 1, 1); PG8_SCHED; PG8_LDA(At, 1, 0); PG8_STAGE(PG8_SA(0, 1), a2 + hstepA, voffA);
            PG8_WAIT_V(8); PG8_WAIT_L(0); PG8_BAR; PG8_MMA(0, 0, At, B0); PG8_MMA(0, 1, At, B1); PG8_BAR; PG8_SCHED;
            PG8_LDA(At, 1, 1); PG8_STAGE(PG8_SB(1, 0), b3, voffB); PG8_STAGE(PG8_SB(1, 1), b3 + hstepB, voffB); PG8_STAGE(PG8_SA(1, 0), a3, voffA);
            PG8_WAIT_V(8); PG8_WAIT_L(0); PG8_BAR; PG8_MMA(1, 0, At, B0); PG8_MMA(1, 1, At, B1); PG8_BAR; PG8_SCHED;
        }
        if constexpr (ALIGN_EPI) { if (wr == 0) PG8_BAR; }
        E(acc, cur, wr, wc, fr, fq); S.done(cur);
        if (!has_next) break;
#pragma unroll
        for (int a = 0; a < 2; ++a)
#pragma unroll
            for (int b = 0; b < 2; ++b)
#pragma unroll
                for (int m = 0; m < 4; ++m)
#pragma unroll
                    for (int n = 0; n < 2; ++n) acc[a][b][m][n] = (f32x4){0.f, 0.f, 0.f, 0.f};
        cur = nxt; cA = nA; cB = nB; ++ui;
        if constexpr (ALIGN_EPI) { if (wr == 1) PG8_BAR; }
    }
    PG8_WAIT_V(0);
    if constexpr (!ALIGN_EPI) { if (wr == 0) PG8_BAR; }
    PG8_BAR;
#undef PG8_SA
#undef PG8_SB
#undef PG8_STAGE
#undef PG8_LDA
#undef PG8_LDB
#undef PG8_MMA
#undef PG8_WAIT_V
#undef PG8_WAIT_L
#undef PG8_BAR
#undef PG8_SCHED
}
}

namespace pg8 {
__device__ __forceinline__ float sigm(float x) { return __builtin_amdgcn_rcpf(1.0f + __builtin_amdgcn_exp2f(-1.4426950408889634f * x)); }
__device__ __forceinline__ float silu(float x) { return x * sigm(x); }
__device__ __forceinline__ float bf_lo(unsigned w) { return __uint_as_float(w << 16); }
__device__ __forceinline__ float bf_hi(unsigned w) { return __uint_as_float(w & 0xffff0000u); }
__device__ __forceinline__ u32x4 pack8(const f32x4 a, const f32x4 b) { u32x4 w; w.x = cvt_pk_bf16(a[0], a[1]); w.y = cvt_pk_bf16(a[2], a[3]); w.z = cvt_pk_bf16(b[0], b[1]); w.w = cvt_pk_bf16(b[2], b[3]); return w; }
__device__ __forceinline__ void unpack8(const u32x4 w, f32x4& a, f32x4& b) { a = (f32x4){bf_lo(w.x), bf_hi(w.x), bf_lo(w.y), bf_hi(w.y)}; b = (f32x4){bf_lo(w.z), bf_hi(w.z), bf_lo(w.w), bf_hi(w.w)}; }

struct EpiIn {
    static constexpr bool PERM = true;
    float* U; bf16_t* Qb; float* FG; bf16_t* Vb; bf16_t* SG; bf16_t* GA; bf16_t* GB; const float* rstd; const float* lb;
    __device__ __forceinline__ void operator()(const f32x4 (&acc)[2][2][4][2], const Unit& u, int wr, int wc, int fr, int fq) const {
        const int pn = u.pn, row0 = u.pm * BM + wr * 64 + fr, cl = wc * 32 + 8 * fq;
        int kind, ld, colt; float* df = nullptr; bf16_t* db = nullptr;
        if (pn < 2)       { kind = 0; df = U;  ld = 512;  colt = 256 * pn; }
        else if (pn < 4)  { kind = 3; db = Qb; ld = 512;  colt = 256 * (pn - 2); }
        else if (pn < 6)  { kind = 1; df = FG; ld = 512;  colt = 256 * (pn - 4); }
        else if (pn < 8)  { kind = 2; db = Vb; ld = 512;  colt = 256 * (pn - 6); }
        else if (pn < 10) { kind = 3; db = SG; ld = 512;  colt = 256 * (pn - 8); }
        else if (pn < 14) { kind = 4; db = GA; ld = 1024; colt = 256 * (pn - 10); }
        else              { kind = 4; db = GB; ld = 1024; colt = 256 * (pn - 14); }
        const int c0 = colt + cl;
        f32x4 l0[2], l1[2];
        if (kind == 1) {
#pragma unroll
            for (int bj = 0; bj < 2; ++bj) { l0[bj] = *(const f32x4*)(lb + c0 + bj * HALF); l1[bj] = *(const f32x4*)(lb + c0 + bj * HALF + 4); }
        }
#pragma unroll
        for (int ai = 0; ai < 2; ++ai)
#pragma unroll
            for (int m = 0; m < 4; ++m) {
                const int row = row0 + ai * HALF + m * 16; const float r = rstd[row];
#pragma unroll
                for (int bj = 0; bj < 2; ++bj) {
                    f32x4 v0 = acc[ai][bj][m][0] * r, v1 = acc[ai][bj][m][1] * r;
                    const size_t off = (size_t)row * ld + c0 + bj * HALF;
                    if (kind <= 1) {
                        if (kind == 1) {
#pragma unroll
                            for (int e = 0; e < 4; ++e) { v0[e] = l0[bj][e] + (1.0f - l0[bj][e]) * sigm(v0[e]); v1[e] = l1[bj][e] + (1.0f - l1[bj][e]) * sigm(v1[e]); }
                        }
                        *(f32x4*)(df + off) = v0; *(f32x4*)(df + off + 4) = v1;
                    } else {
                        if (kind == 3) {
#pragma unroll
                            for (int e = 0; e < 4; ++e) { v0[e] = silu(v0[e]); v1[e] = silu(v1[e]); }
                        } else if (kind == 4) {
#pragma unroll
                            for (int e = 0; e < 4; ++e) { v0[e] = sigm(v0[e]); v1[e] = sigm(v1[e]); }
                        }
                        *(u32x4*)(db + off) = pack8(v0, v1);
                    }
                }
            }
    }
};

struct EpiGateA {
    static constexpr bool PERM = true;
    float* T; const bf16_t* GA;
    __device__ __forceinline__ void operator()(const f32x4 (&acc)[2][2][4][2], const Unit& u, int wr, int wc, int fr, int fq) const {
        const int row0 = u.pm * BM + wr * 64 + fr, c0 = u.pn * BM + wc * 32 + 8 * fq;
#pragma unroll
        for (int ai = 0; ai < 2; ++ai)
#pragma unroll
            for (int m = 0; m < 4; ++m) {
                const int row = row0 + ai * HALF + m * 16;
#pragma unroll
                for (int bj = 0; bj < 2; ++bj) {
                    const size_t off = (size_t)row * 1024 + c0 + bj * HALF;
                    f32x4 g0, g1; unpack8(*(const u32x4*)(GA + off), g0, g1);
                    *(f32x4*)(T + off) = acc[ai][bj][m][0] * g0; *(f32x4*)(T + off + 4) = acc[ai][bj][m][1] * g1;
                }
            }
    }
};
struct EpiGateB {
    static constexpr bool PERM = true;
    const float* T; const bf16_t* GB; bf16_t* MG;
    __device__ __forceinline__ void operator()(const f32x4 (&acc)[2][2][4][2], const Unit& u, int wr, int wc, int fr, int fq) const {
        const int row0 = u.pm * BM + wr * 64 + fr, c0 = u.pn * BM + wc * 32 + 8 * fq;
#pragma unroll
        for (int ai = 0; ai < 2; ++ai)
#pragma unroll
            for (int m = 0; m < 4; ++m) {
                const int row = row0 + ai * HALF + m * 16;
#pragma unroll
                for (int bj = 0; bj < 2; ++bj) {
                    const size_t off = (size_t)row * 1024 + c0 + bj * HALF;
                    f32x4 g0, g1; unpack8(*(const u32x4*)(GB + off), g0, g1);
                    const f32x4 t0 = *(const f32x4*)(T + off), t1 = *(const f32x4*)(T + off + 4);
                    *(u32x4*)(MG + off) = pack8(t0 + acc[ai][bj][m][0] * g0, t1 + acc[ai][bj][m][1] * g1);
                }
            }
    }
};
struct EpiRes {
    static constexpr bool PERM = true;
    const float* base_lo; const float* base_hi; float* out; bf16_t* outb; float* ssq;
    __device__ __forceinline__ void operator()(const f32x4 (&acc)[2][2][4][2], const Unit& u, int wr, int wc, int fr, int fq) const {
        const int row0 = u.pm * BM + wr * 64 + fr, c0 = u.pn * BM + wc * 32 + 8 * fq;
        const float* base = (u.pm < 64) ? base_lo : base_hi;
#pragma unroll
        for (int ai = 0; ai < 2; ++ai)
#pragma unroll
            for (int m = 0; m < 4; ++m) {
                const int row = row0 + ai * HALF + m * 16; float s = 0.f;
#pragma unroll
                for (int bj = 0; bj < 2; ++bj) {
                    const size_t off = (size_t)row * 1024 + c0 + bj * HALF;
                    const f32x4 v0 = *(const f32x4*)(base + off) + acc[ai][bj][m][0], v1 = *(const f32x4*)(base + off + 4) + acc[ai][bj][m][1];
                    *(f32x4*)(out + off) = v0; *(f32x4*)(out + off + 4) = v1;
                    *(u32x4*)(outb + off) = pack8(v0, v1);
                    s += (v0[0] * v0[0] + v0[1] * v0[1]) + (v0[2] * v0[2] + v0[3] * v0[3]) + (v1[0] * v1[0] + v1[1] * v1[1]) + (v1[2] * v1[2] + v1[3] * v1[3]);
                }
                s += __shfl_xor(s, 16); s += __shfl_xor(s, 32);
                if (fq == 0) unsafeAtomicAdd(ssq + row, s);
                if (m & 1) asm volatile("" ::: "memory");
            }
    }
};
struct EpiSwiGLU {
    static constexpr bool PERM = true;
    bf16_t* ACT; const float* ssq;
    __device__ __forceinline__ void operator()(const f32x4 (&acc)[2][2][4][2], const Unit& u, int wr, int wc, int fr, int fq) const {
        const int row0 = u.pm * BM + wr * 64 + fr, c0 = u.pn * HALF + wc * 32 + 8 * fq;
#pragma unroll
        for (int ai = 0; ai < 2; ++ai)
#pragma unroll
            for (int m = 0; m < 4; ++m) {
                const int row = row0 + ai * HALF + m * 16; const float r = __builtin_amdgcn_rsqf(ssq[row] * (1.0f / 1024.0f) + EPS);
                f32x4 a0 = acc[ai][0][m][0] * r, a1 = acc[ai][0][m][1] * r; const f32x4 u0 = acc[ai][1][m][0] * r, u1 = acc[ai][1][m][1] * r;
#pragma unroll
                for (int e = 0; e < 4; ++e) { a0[e] = silu(a0[e]) * u0[e]; a1[e] = silu(a1[e]) * u1[e]; }
                *(u32x4*)(ACT + (size_t)row * FF + c0) = pack8(a0, a1);
            }
    }
};
struct EpiBf {
    static constexpr bool PERM = true;
    bf16_t* O;
    __device__ __forceinline__ void operator()(const f32x4 (&acc)[2][2][4][2], const Unit& u, int wr, int wc, int fr, int fq) const {
        const int row0 = u.pm * BM + wr * 64 + fr, c0 = u.pn * BM + wc * 32 + 8 * fq;
#pragma unroll
        for (int ai = 0; ai < 2; ++ai)
#pragma unroll
            for (int m = 0; m < 4; ++m) {
                const int row = row0 + ai * HALF + m * 16;
#pragma unroll
                for (int bj = 0; bj < 2; ++bj) *(u32x4*)(O + (size_t)row * 1024 + c0 + bj * HALF) = pack8(acc[ai][bj][m][0], acc[ai][bj][m][1]);
            }
    }
};
struct EpiPle {
    static constexpr bool PERM = true;
    float* X; const bf16_t* EMB; const float* ssq_in; float* ssq_out;
    __device__ __forceinline__ void operator()(const f32x4 (&acc)[2][2][4][2], const Unit& u, int wr, int wc, int fr, int fq) const {
        const int row0 = u.pm * BM + wr * 64 + fr, c0 = u.pn * BM + wc * 32 + 8 * fq;
#pragma unroll
        for (int ai = 0; ai < 2; ++ai)
#pragma unroll
            for (int m = 0; m < 4; ++m) {
                const int row = row0 + ai * HALF + m * 16; const float r = __builtin_amdgcn_rsqf(ssq_in[row] * (1.0f / 1024.0f) + EPS); float s = 0.f;
#pragma unroll
                for (int bj = 0; bj < 2; ++bj) {
                    const size_t off = (size_t)row * 1024 + c0 + bj * HALF;
                    f32x4 e0, e1; unpack8(*(const u32x4*)(EMB + off), e0, e1);
                    f32x4 v0 = *(const f32x4*)(X + off), v1 = *(const f32x4*)(X + off + 4);
#pragma unroll
                    for (int e = 0; e < 4; ++e) { v0[e] += sigm(acc[ai][bj][m][0][e] * r) * e0[e]; v1[e] += sigm(acc[ai][bj][m][1][e] * r) * e1[e]; }
                    *(f32x4*)(X + off) = v0; *(f32x4*)(X + off + 4) = v1;
                    s += (v0[0] * v0[0] + v0[1] * v0[1]) + (v0[2] * v0[2] + v0[3] * v0[3]) + (v1[0] * v1[0] + v1[1] * v1[1]) + (v1[2] * v1[2] + v1[3] * v1[3]);
                }
                s += __shfl_xor(s, 16); s += __shfl_xor(s, 32);
                if (fq == 0) unsafeAtomicAdd(ssq_out + row, s);
                if (m & 1) asm volatile("" ::: "memory");
            }
    }
};
}

constexpr int NWAVES = 8;
constexpr size_t MiB = 1u << 20;
constexpr size_t WS_CTL = 0, CTL_ZERO_BYTES = 1 * MiB;
constexpr size_t WS_SMALL = 1 * MiB;
constexpr size_t SM_LB = 0, SM_RSTD0 = 4096, SM_SSQ1 = SM_RSTD0 + 69632 * 1, SM_SSQ2 = SM_SSQ1 + 69632, SM_SSQ3 = SM_SSQ2 + 69632;
constexpr size_t WS_WIN = 2 * MiB;
constexpr size_t WS_WAB = 11 * MiB;
constexpr size_t WS_WOUT = 13 * MiB;
constexpr size_t WS_WGU = 15 * MiB;
constexpr size_t WS_WDN = 26 * MiB;
constexpr size_t WS_WPG = 32 * MiB;
constexpr size_t WS_WPP = 34 * MiB;
constexpr size_t WS_PB = 35 * MiB;
constexpr size_t WS_XB = 44 * MiB;
constexpr size_t WS_QB = 78 * MiB;
constexpr size_t WS_VB = 95 * MiB;
constexpr size_t WS_SG = 112 * MiB;
constexpr size_t WS_GA = 129 * MiB;
constexpr size_t WS_GB = 163 * MiB;
constexpr size_t WS_O = 197 * MiB;
constexpr size_t WS_ACT = 78 * MiB;
constexpr size_t WS_END = 232 * MiB;
static_assert(WS_ACT + (size_t)M * FF * 2 <= WS_O, "act overlay");
static_assert(WS_WDN + (size_t)D * FF * 2 <= WS_WPG && WS_WPP + (size_t)D * PD * 2 <= WS_PB && WS_PB + (size_t)M * PD * 2 <= WS_XB && WS_XB + (size_t)M * D * 2 <= WS_QB, "ws map");
static_assert(WS_GB + (size_t)M * D * 2 <= WS_O && WS_O + (size_t)M * PW * 4 <= WS_END, "ws map 2");
constexpr size_t OUT_Y = 0, OUT_NPP = (size_t)M * D, OUT_NHP = OUT_NPP + (size_t)NB * PBUF * PW, OUT_NPS = OUT_NHP + (size_t)NB * NH * DK * DV, OUT_NHS = OUT_NPS + (size_t)DB * PBUF * PW,
                 OUT_END = OUT_NHS + (size_t)DB * NH * DK * DV;

constexpr int RING_BYTES = 131072, MISC_OFF = RING_BYTES, LDS_BYTES = 147456;

#define LAS __attribute__((address_space(3)))
typedef unsigned short bf16;
typedef unsigned v4u __attribute__((ext_vector_type(4)));
typedef unsigned v2u __attribute__((ext_vector_type(2)));
typedef float f32x4 __attribute__((ext_vector_type(4)));
#define LDS_WAIT() asm volatile("s_waitcnt lgkmcnt(0)" ::: "memory")
__device__ __forceinline__ unsigned pk2(float lo, float hi) { return pg8::cvt_pk_bf16(lo, hi); }
__device__ __forceinline__ float bf2f(bf16 v) { return __uint_as_float((unsigned)v << 16); }
__device__ __forceinline__ float wave_sum(float v) {
#pragma unroll
    for (int o = 1; o < 64; o <<= 1) v += __shfl_xor(v, o);
    return v;
}

struct Frame {
    LAS unsigned char* lds;
    int tid, lane, wave, G, wg;
    float* out; unsigned char* ws;
};
struct Args { const float* in[23]; float* out; unsigned char* ws; int ph_lo, ph_hi; };
static_assert(sizeof(Args) == 23 * 8 + 8 + 8 + 8, "Args has no padding");
enum { I_XP = 0, I_XS, I_SPOOL, I_SHGRN, I_PP, I_PS, I_GMIX, I_WIN, I_WPMIX, I_PSCALE, I_HLB, I_HNORM, I_WPUP, I_WHUP, I_WOUT, I_GFFN, I_WFG, I_WFU, I_WFD, I_GPLE, I_WPG, I_WPPJ, I_GFIN };

__device__ __forceinline__ void p0_transpose_item(const float* W, int N, const float* gain, bf16* WT, int ldk, int drow, int k0, int n0, int koff, LAS float* scr, int lane) {
#pragma unroll 8
    for (int i = 0; i < 32; ++i) { const int kk = 2 * i + (lane >> 5); float v = W[(size_t)(k0 + kk) * N + n0 + (lane & 31)]; if (gain) v *= gain[k0 + kk]; scr[kk * 33 + (lane & 31)] = v; }
    LDS_WAIT(); asm volatile("" ::: "memory");
    const int c = lane & 7;
#pragma unroll
    for (int j = 0; j < 4; ++j) { const int n = (lane >> 3) + 8 * j; const LAS float* s = scr + (8 * c) * 33 + n;
        v4u o; o.x = pk2(s[0 * 33], s[1 * 33]); o.y = pk2(s[2 * 33], s[3 * 33]); o.z = pk2(s[4 * 33], s[5 * 33]); o.w = pk2(s[6 * 33], s[7 * 33]);
        *(v4u*)(WT + (size_t)(drow + n) * ldk + koff + k0 + 8 * c) = o; }
    LDS_WAIT(); asm volatile("" ::: "memory");
}
__device__ __forceinline__ void p0_fold_item(const float* w_pool_mix, const float* w_pool_up, const float* pool_scale, bf16* WAB, int item, int lane) {
    const int g = item >> 7, cb = (item >> 4) & 7, nb = item & 15, n = nb * 64 + lane, c0 = cb * 16;
    float a[16];
#pragma unroll
    for (int c = 0; c < 16; ++c) a[c] = 0.f;
    const float* mix = w_pool_mix + (size_t)g * 128 * 128 + (size_t)c0 * 128;
    for (int d = 0; d < 128; ++d) {
        const float w = w_pool_up[(size_t)(g * 128 + d) * D + n] * pool_scale[g * 128 + d];
#pragma unroll
        for (int c = 0; c < 16; ++c) a[c] += mix[c * 128 + d] * w;
    }
    v4u o0, o1; o0.x = pk2(a[0], a[1]); o0.y = pk2(a[2], a[3]); o0.z = pk2(a[4], a[5]); o0.w = pk2(a[6], a[7]); o1.x = pk2(a[8], a[9]); o1.y = pk2(a[10], a[11]); o1.z = pk2(a[12], a[13]); o1.w = pk2(a[14], a[15]);
    bf16* dst = WAB + (size_t)n * 1024 + g * 128 + c0; *(v4u*)dst = o0; *(v4u*)(dst + 8) = o1;
}
__device__ __forceinline__ void p0_prologue(const Frame& F, const Args& A) {
    LAS float* scr = (LAS float*)(F.lds + F.wave * 16384);
    const int gw = F.wg * NWAVES + F.wave, NGW = F.G * NWAVES, lane = F.lane;
    unsigned char* ws = F.ws;
    bf16 *WIN = (bf16*)(ws + WS_WIN), *WAB = (bf16*)(ws + WS_WAB), *WOUT = (bf16*)(ws + WS_WOUT), *WGU = (bf16*)(ws + WS_WGU), *WDN = (bf16*)(ws + WS_WDN), *WPG = (bf16*)(ws + WS_WPG), *WPP = (bf16*)(ws + WS_WPP);
    constexpr int NI_IN = 16 * 144, NI_HU = 8 * 32, NI_OUT = 16 * 32, NI_G = 16 * 88, NI_DN = 44 * 32, NI_PG = 16 * 32, NI_PP = 4 * 32, NI_FOLD = 512;
    constexpr int NITEMS = NI_IN + NI_HU + NI_OUT + 2 * NI_G + NI_DN + NI_PG + NI_PP + NI_FOLD;
    for (int it = gw; it < NITEMS; it += NGW) {
        int r = it;
        if (r < NI_IN) { const int kb = r / 144, nb = r % 144; p0_transpose_item(A.in[I_WIN], NIN, A.in[I_GMIX], WIN, 1024, 32 * nb, 64 * kb, 32 * nb, 0, scr, lane); continue; } r -= NI_IN;
        if (r < NI_HU) { const int kb = r / 32, nb = r % 32; p0_transpose_item(A.in[I_WHUP], D, nullptr, WAB, 1024, 32 * nb, 64 * kb, 32 * nb, 512, scr, lane); continue; } r -= NI_HU;
        if (r < NI_OUT) { const int kb = r / 32, nb = r % 32; p0_transpose_item(A.in[I_WOUT], D, nullptr, WOUT, 1024, 32 * nb, 64 * kb, 32 * nb, 0, scr, lane); continue; } r -= NI_OUT;
        if (r < NI_G) { const int kb = r / 88, nb = r % 88, n0 = 32 * nb; p0_transpose_item(A.in[I_WFG], FF, A.in[I_GFFN], WGU, 1024, (n0 >> 7) * 256 + (n0 & 127), 64 * kb, n0, 0, scr, lane); continue; } r -= NI_G;
        if (r < NI_G) { const int kb = r / 88, nb = r % 88, n0 = 32 * nb; p0_transpose_item(A.in[I_WFU], FF, A.in[I_GFFN], WGU, 1024, (n0 >> 7) * 256 + 128 + (n0 & 127), 64 * kb, n0, 0, scr, lane); continue; } r -= NI_G;
        if (r < NI_DN) { const int kb = r / 32, nb = r % 32; p0_transpose_item(A.in[I_WFD], D, nullptr, WDN, FF, 32 * nb, 64 * kb, 32 * nb, 0, scr, lane); continue; } r -= NI_DN;
        if (r < NI_PG) { const int kb = r / 32, nb = r % 32; p0_transpose_item(A.in[I_WPG], D, A.in[I_GPLE], WPG, 1024, 32 * nb, 64 * kb, 32 * nb, 0, scr, lane); continue; } r -= NI_PG;
        if (r < NI_PP) { const int kb = r / 32, nb = r % 32; p0_transpose_item(A.in[I_WPPJ], D, nullptr, WPP, 256, 32 * nb, 64 * kb, 32 * nb, 0, scr, lane); continue; } r -= NI_PP;
        p0_fold_item(A.in[I_WPMIX], A.in[I_WPUP], A.in[I_PSCALE], WAB, r, lane);
    }
    bf16* XB = (bf16*)(ws + WS_XB); bf16* PB = (bf16*)(ws + WS_PB);
    float* small = (float*)(ws + WS_SMALL);
    float* RSTD0 = (float*)((char*)small + SM_RSTD0); float* SSQ1 = (float*)((char*)small + SM_SSQ1);
    for (int m = gw; m < M; m += NGW) {
        const float* xrow = (m < MP) ? A.in[I_XP] + (size_t)m * D : A.in[I_XS] + (size_t)(m - MP) * D;
        const f32x4* xr = (const f32x4*)xrow + lane; f32x4 v[4]; float s = 0.f;
#pragma unroll
        for (int j = 0; j < 4; ++j) { v[j] = xr[64 * j]; s += (v[j].x * v[j].x + v[j].y * v[j].y) + (v[j].z * v[j].z + v[j].w * v[j].w); }
        s = wave_sum(s);
        v2u* o8 = (v2u*)(XB + (size_t)m * D) + lane;
#pragma unroll
        for (int j = 0; j < 4; ++j) { v2u w; w.x = pk2(v[j].x, v[j].y); w.y = pk2(v[j].z, v[j].w); o8[64 * j] = w; }
        const float* prow = (m < MP) ? A.in[I_PP] + (size_t)m * PD : A.in[I_PS] + (size_t)(m - MP) * PD;
        const f32x4 pv = ((const f32x4*)prow)[lane]; v2u pw; pw.x = pk2(pv.x, pv.y); pw.y = pk2(pv.z, pv.w); ((v2u*)(PB + (size_t)m * PD))[lane] = pw;
        if (lane == 0) { RSTD0[m] = 1.0f / sqrtf(s * (1.0f / D) + EPS); }
        if (lane < 3) SSQ1[lane * M + m] = 0.f;
    }
    if (F.wg == 0) { float* LB = (float*)((char*)small + SM_LB); const int c = F.tid; if (c < 512) { const float a0 = A.in[I_HLB][c], a1 = A.in[I_HLB][512 + c]; LB[c] = 1.0f / (1.0f + expf(a1 - a0)); } }
}

__device__ __forceinline__ void p2_pool(const Frame& F, const Args& A) {
    const float* U = F.out + OUT_Y; bf16* AB = (bf16*)(F.ws + WS_XB);
    const int gt = F.wg * (NWAVES * 64) + F.tid, NT = F.G * NWAVES * 64;
    for (int idx = gt; idx < M * PW; idx += NT) {
        const int m = idx >> 9, c = idx & 511, g = c >> 7, w = 2 << g; float s = 0.f; int cnt;
        if (m < MP) { const int t = m & (SEQ - 1); cnt = (t + 1 < w) ? t + 1 : w; for (int j = 0; j < cnt; ++j) s += U[(size_t)(m - j) * PW + c]; }
        else { const int ms = m - MP, b = ms >> 3, t = ms & 7; cnt = w;
            for (int j = 0; j < w; ++j) s += (t - j >= 0) ? U[(size_t)(m - j) * PW + c] : A.in[I_SPOOL][((size_t)b * PBUF + (PBUF + t - j)) * PW + c]; }
        const float pooled = s / (float)cnt - U[(size_t)m * PW + c];
        AB[(size_t)m * 1024 + c] = (bf16)(pk2(pooled, 0.f) & 0xffffu);
    }
    float* NPP = F.out + OUT_NPP; float* NPS = F.out + OUT_NPS;
    for (int idx = gt; idx < NB * PBUF * PW; idx += NT) { const int c = idx & 511, i = (idx >> 9) % PBUF, b = (idx >> 9) / PBUF; NPP[idx] = U[((size_t)b * SEQ + SEQ - PBUF + i) * PW + c]; }
    for (int idx = gt; idx < DB * PBUF * PW; idx += NT) { const int c = idx & 511, i = (idx >> 9) % PBUF, b = (idx >> 9) / PBUF;
        NPS[idx] = (i < 7) ? A.in[I_SPOOL][((size_t)b * PBUF + 8 + i) * PW + c] : U[((size_t)MP + b * DS + (i - 7)) * PW + c]; }
}

__device__ __forceinline__ void p2_rec_item(const Frame& F, const Args& A, int item) {
    const float* FG = F.out + OUT_Y + (size_t)M * PW; const bf16* QB = (const bf16*)(F.ws + WS_QB); const bf16* VB = (const bf16*)(F.ws + WS_VB); float* O = (float*)(F.ws + WS_O);
    LAS float* Fs = (LAS float*)(F.lds); LAS float* Qs = Fs + 32 * 128; LAS float* Vs = Qs + 32 * 128; LAS float* Os = Vs + 32 * 64;
    const int tid = F.tid, vi = tid >> 3, kg = tid & 7;
    int T, row0, h, vh; const float* s0 = nullptr; float* sout;
    if (item < 64) { const int bh = item >> 1; vh = item & 1; const int b = bh >> 2; h = bh & 3; T = SEQ; row0 = b * SEQ; sout = F.out + OUT_NHP + (size_t)bh * DK * DV; }
    else { const int it = item - 64, bh = it >> 1; vh = it & 1; const int b = bh >> 2; h = bh & 3; T = DS; row0 = MP + b * DS; s0 = A.in[I_SHGRN] + (size_t)bh * DK * DV; sout = F.out + OUT_NHS + (size_t)bh * DK * DV; }
    float S[16];
#pragma unroll
    for (int i = 0; i < 16; ++i) S[i] = s0 ? s0[(size_t)(kg * 16 + i) * DV + vh * 64 + vi] : 0.f;
    for (int t0 = 0; t0 < T; t0 += 32) {
        const int nt = (T - t0 < 32) ? T - t0 : 32;
        for (int idx = tid; idx < nt * 128; idx += 512) { const int tt = idx >> 7, k = idx & 127; const size_t g = (size_t)(row0 + t0 + tt) * HW + h * 128 + k; Fs[idx] = FG[g]; Qs[idx] = bf2f(QB[g]); }
        for (int idx = tid; idx < nt * 64; idx += 512) { const int tt = idx >> 6, v = idx & 63; Vs[idx] = bf2f(VB[(size_t)(row0 + t0 + tt) * HW + h * 128 + vh * 64 + v]); }
        __syncthreads();
        for (int tt = 0; tt < nt; ++tt) {
            const float v = Vs[tt * 64 + vi]; float a = 0.f;
            const LAS f32x4* fp = (const LAS f32x4*)(Fs + tt * 128 + kg * 16); const LAS f32x4* qp = (const LAS f32x4*)(Qs + tt * 128 + kg * 16);
#pragma unroll
            for (int i4 = 0; i4 < 4; ++i4) { const f32x4 f = fp[i4], q = qp[i4];
#pragma unroll
                for (int e = 0; e < 4; ++e) { const int i = i4 * 4 + e; S[i] = f[e] * S[i] + (1.0f - f[e]) * v; a += S[i] * q[e]; } }
            a += __shfl_xor(a, 1); a += __shfl_xor(a, 2); a += __shfl_xor(a, 4);
            if (kg == 0) Os[tt * 64 + vi] = a;
        }
        __syncthreads();
        for (int idx = tid; idx < nt * 64; idx += 512) { const int tt = idx >> 6, v = idx & 63; O[(size_t)(row0 + t0 + tt) * HW + h * 128 + vh * 64 + v] = Os[idx]; }
    }
#pragma unroll
    for (int i = 0; i < 16; ++i) sout[(size_t)(kg * 16 + i) * DV + vh * 64 + vi] = S[i];
    __syncthreads();
}
__device__ __forceinline__ void p2_onorm(const Frame& F, const Args& A) {
    const float* O = (const float*)(F.ws + WS_O); const bf16* SG = (const bf16*)(F.ws + WS_SG); bf16* AB = (bf16*)(F.ws + WS_XB);
    const int gw = F.wg * NWAVES + F.wave, NGW = F.G * NWAVES, lane = F.lane;
    for (int m = gw; m < M; m += NGW) {
        const f32x4 a = *(const f32x4*)(O + (size_t)m * HW + lane * 8), b = *(const f32x4*)(O + (size_t)m * HW + lane * 8 + 4);
        float s = (a.x * a.x + a.y * a.y) + (a.z * a.z + a.w * a.w) + (b.x * b.x + b.y * b.y) + (b.z * b.z + b.w * b.w);
        s += __shfl_xor(s, 1); s += __shfl_xor(s, 2); s += __shfl_xor(s, 4); s += __shfl_xor(s, 8);
        const float r = 1.0f / sqrtf(s * (1.0f / DV) + EPS);
        const f32x4 n0 = *(const f32x4*)(A.in[I_HNORM] + lane * 8), n1 = *(const f32x4*)(A.in[I_HNORM] + lane * 8 + 4);
        const v4u gw4 = *(const v4u*)(SG + (size_t)m * HW + lane * 8); f32x4 g0, g1; pg8::unpack8(gw4, g0, g1);
        *(v4u*)(AB + (size_t)m * 1024 + 512 + lane * 8) = pg8::pack8(a * r * n0 * g0, b * r * n1 * g1);
    }
}
__device__ __forceinline__ void p_final(const Frame& F, const Args& A) {
    float* Y = F.out + OUT_Y; const float* SSQ3 = (const float*)(F.ws + WS_SMALL + SM_SSQ3);
    const int gw = F.wg * NWAVES + F.wave, NGW = F.G * NWAVES, lane = F.lane;
    f32x4 gf[4];
#pragma unroll
    for (int j = 0; j < 4; ++j) gf[j] = ((const f32x4*)A.in[I_GFIN])[lane + 64 * j];
    for (int m = gw; m < M; m += NGW) {
        const float r = 1.0f / sqrtf(SSQ3[m] * (1.0f / D) + EPS);
        f32x4* yr = (f32x4*)(Y + (size_t)m * D) + lane;
#pragma unroll
        for (int j = 0; j < 4; ++j) yr[64 * j] = yr[64 * j] * r * gf[j];
    }
}

#ifndef MK_N_LAUNCHES
#define MK_N_LAUNCHES 1
#endif
constexpr int N_PHASES = 12;

__global__ void __launch_bounds__(NWAVES * 64, 2) fwd_kernel(Args args) {
    extern __shared__ __attribute__((aligned(16))) unsigned char lds_raw[];
    Frame F;
    F.lds = (LAS unsigned char*)lds_raw;
    F.tid = threadIdx.x; F.lane = F.tid & 63; F.wave = __builtin_amdgcn_readfirstlane(F.tid >> 6);
    F.G = gridDim.x; F.wg = blockIdx.x;
    F.out = args.out; F.ws = args.ws;
    unsigned char* ws = args.ws;
    const int lo = args.ph_lo, hi = args.ph_hi;
#ifndef PHASE_MASK
#define PHASE_MASK 0xfff
#endif
#define IN(k) (((PHASE_MASK >> (k)) & 1) && lo <= (k) && (k) < hi)
#define SEAM(k) do { if (IN(k) && IN((k) + 1)) { cg::this_grid().sync(); } } while (0)
    using namespace pg8;
    float* small = (float*)(ws + WS_SMALL);
    float* LB = (float*)((char*)small + SM_LB); float* RSTD0 = (float*)((char*)small + SM_RSTD0);
    float* SSQ1 = (float*)((char*)small + SM_SSQ1); float* SSQ2 = (float*)((char*)small + SM_SSQ2); float* SSQ3 = (float*)((char*)small + SM_SSQ3);
    bf16_t *WIN = (bf16_t*)(ws + WS_WIN), *WAB = (bf16_t*)(ws + WS_WAB), *WOUT = (bf16_t*)(ws + WS_WOUT), *WGU = (bf16_t*)(ws + WS_WGU), *WDN = (bf16_t*)(ws + WS_WDN), *WPG = (bf16_t*)(ws + WS_WPG), *WPP = (bf16_t*)(ws + WS_WPP);
    bf16_t *PB = (bf16_t*)(ws + WS_PB), *XB = (bf16_t*)(ws + WS_XB), *QB = (bf16_t*)(ws + WS_QB), *VB = (bf16_t*)(ws + WS_VB), *SG = (bf16_t*)(ws + WS_SG), *GA = (bf16_t*)(ws + WS_GA), *GB = (bf16_t*)(ws + WS_GB);
    bf16_t *MG = (bf16_t*)(ws + WS_O), *EMB = (bf16_t*)(ws + WS_O), *ACT = (bf16_t*)(ws + WS_ACT);
    float* Y = F.out + OUT_Y; float* U = Y; float* FGp = Y + (size_t)M * PW; float* T = Y;
    const int c = (int)blockIdx.x;

    if (IN(0)) { p0_prologue(F, args); } SEAM(0);
    if (IN(1)) {
        Gemm g{XB, WIN, M, NIN, D, D, D}; StaticOrder S; S.init(M, NIN, F.G, c);
        EpiIn E{U, QB, FGp, VB, SG, GA, GB, RSTD0, LB};
        gemm_phase<EpiIn, StaticOrder, true>(F.lds, g, S, E);
    } SEAM(1);
    if (IN(2)) { p2_pool(F, args); for (int it = F.wg; it < 64 + 1024; it += F.G) p2_rec_item(F, args, it); } SEAM(2);
    if (IN(3)) { p2_onorm(F, args); } SEAM(3);
    if (IN(4)) {
        Gemm g{XB, WAB, M, D, 512, D, D}; StaticOrder S; S.init(M, D, F.G, c);
        EpiGateA E{T, GA};
        gemm_phase<EpiGateA, StaticOrder, true>(F.lds, g, S, E);
    } SEAM(4);
    if (IN(5)) {
        Gemm g{XB + 512, WAB + 512, M, D, 512, D, D}; StaticOrder S; S.init(M, D, F.G, c);
        EpiGateB E{T, GB, MG};
        gemm_phase<EpiGateB, StaticOrder, true>(F.lds, g, S, E);
    } SEAM(5);
    if (IN(6)) {
        Gemm g{MG, WOUT, M, D, D, D, D}; StaticOrder S; S.init(M, D, F.G, c);
        EpiRes E{args.in[I_XP], args.in[I_XS] - (size_t)MP * D, Y, XB, SSQ1};
        gemm_phase<EpiRes, StaticOrder, true>(F.lds, g, S, E);
    } SEAM(6);
    if (IN(7)) {
        Gemm g{XB, WGU, M, 2 * FF, D, D, D}; StaticOrder S; S.init(M, 2 * FF, F.G, c);
        EpiSwiGLU E{ACT, SSQ1};
        gemm_phase<EpiSwiGLU, StaticOrder, true>(F.lds, g, S, E);
    } SEAM(7);
    if (IN(8)) {
        Gemm g{ACT, WDN, M, D, FF, FF, FF}; StaticOrder S; S.init(M, D, F.G, c);
        EpiRes E{Y, Y, Y, XB, SSQ2};
        gemm_phase<EpiRes, StaticOrder, true>(F.lds, g, S, E);
    } SEAM(8);
    if (IN(9)) {
        Gemm g{PB, WPP, M, D, PD, PD, PD}; StaticOrder S; S.init(M, D, F.G, c);
        EpiBf E{EMB};
        gemm_phase<EpiBf, StaticOrder, true>(F.lds, g, S, E);
    } SEAM(9);
    if (IN(10)) {
        Gemm g{XB, WPG, M, D, D, D, D}; StaticOrder S; S.init(M, D, F.G, c);
        EpiPle E{Y, EMB, SSQ2, SSQ3};
        gemm_phase<EpiPle, StaticOrder, true>(F.lds, g, S, E);
    } SEAM(10);
    if (IN(11)) { p_final(F, args); }
#undef IN
#undef SEAM
}

extern "C" void kernel_launch(void* const* d_in, const int* in_sizes, int n_in, void* d_out, int out_size, void* d_ws, size_t ws_size, hipStream_t stream) {
    static int grid = 0;
    if (grid == 0) {
        if (n_in != 23 || in_sizes[0] != MP * D || (size_t)out_size != OUT_END || ws_size < WS_END) { fprintf(stderr, "kernel_launch: unexpected shapes (n_in %d, in0 %d, out %d, ws %zu)\n", n_in, n_in > 0 ? in_sizes[0] : -1, out_size, ws_size); grid = -1; return; }
        int dev = 0, cus = 0, per_cu = 0;
        if (hipGetDevice(&dev) != hipSuccess || hipDeviceGetAttribute(&cus, hipDeviceAttributeMultiprocessorCount, dev) != hipSuccess) { grid = -1; return; }
        if (hipFuncSetAttribute((const void*)fwd_kernel, hipFuncAttributeMaxDynamicSharedMemorySize, LDS_BYTES) != hipSuccess) { fprintf(stderr, "kernel_launch: hipFuncSetAttribute failed\n"); grid = -1; return; }
        if (hipOccupancyMaxActiveBlocksPerMultiprocessor(&per_cu, (const void*)fwd_kernel, NWAVES * 64, LDS_BYTES) != hipSuccess || per_cu < 1) { fprintf(stderr, "kernel_launch: occupancy query says %d blocks per CU\n", per_cu); (void)hipGetLastError(); grid = -1; return; }
        grid = cus * per_cu;
    }
    if (grid < 0) return;
    (void)hipMemsetAsync((char*)d_ws + WS_CTL, 0, CTL_ZERO_BYTES, stream);
    Args a{};
    for (int i = 0; i < 23; ++i) a.in[i] = (const float*)d_in[i];
    a.out = (float*)d_out; a.ws = (unsigned char*)d_ws;
#if MK_N_LAUNCHES == 1
    a.ph_lo = 0; a.ph_hi = N_PHASES;
    void* kargs[] = {&a};
    hipError_t e = hipLaunchCooperativeKernel((const void*)fwd_kernel, dim3(grid), dim3(NWAVES * 64), kargs, LDS_BYTES, stream);
    if (e != hipSuccess) fprintf(stderr, "cooperative launch failed: %s (grid %d)\n", hipGetErrorString(e), grid);
#else
    for (int ph = 0; ph < N_PHASES; ++ph) {
        a.ph_lo = ph; a.ph_hi = ph + 1;
        hipLaunchKernelGGL(fwd_kernel, dim3(grid), dim3(NWAVES * 64), LDS_BYTES, stream, a);
    }
#endif
}
```

```cpp
#include <hip/hip_runtime.h>
#include <hip/hip_cooperative_groups.h>
#include <cstdio>
#include <cstdint>
namespace cg = cooperative_groups;

constexpr int D = 1024, SEQ = 2048, NB = 8, DB = 128, DS = 8;
constexpr int MP = NB * SEQ;
constexpr int MS = DB * DS;
constexpr int M = MP + MS;
constexpr int PW = 512, HW = 512, NH = 4, DK = 128, DV = 128, PBUF = 15;
constexpr int FF = 2816, PD = 256, NIN = 4608;
constexpr float EPS = 1e-6f;

namespace pg8 {
#define PG8_LAS __attribute__((address_space(3)))
typedef unsigned short bf16_t;
typedef short bf16x8 __attribute__((ext_vector_type(8)));
typedef float f32x4 __attribute__((ext_vector_type(4)));
typedef float f32x2 __attribute__((ext_vector_type(2)));
typedef unsigned u32x4 __attribute__((ext_vector_type(4)));
typedef unsigned u32x2 __attribute__((ext_vector_type(2)));
constexpr int BM = 256, BK = 64, HALF = 128, HTB = HALF * BK * 2  , STAGE_BYTES = 8 * HTB, NXCD = 8, WGM = 8;

__host__ __device__ __forceinline__ int lds_byte(int r, int c) { const int st = (r >> 4) * 2 + (c >> 5), rr = r & 15, cc = c & 31, ob = rr * 64 + cc * 2; return st * 1024 + (ob ^ (((ob >> 9) & 1) << 5)); }
__host__ __device__ __forceinline__ void stage_rc(int b, int& R, int& C) { const int st = b / 1024, sb = b % 1024, swz = sb ^ (((sb >> 9) & 1) << 5); R = (st >> 1) * 16 + swz / 64; C = (st & 1) * 32 + (swz % 64) / 2; }
__host__ __device__ __forceinline__ int perm32(int rho) { const int n = rho >> 4, i = rho & 15; return 8 * (i >> 2) + 4 * n + (i & 3); }

struct Unit { int pm, pn; };
struct Gemm { const bf16_t* A; const bf16_t* Bt; int M, N, K, lda, ldb; };

struct StaticOrder {
    int nM, nN, nwg, G, c;
    __host__ __device__ void init(int M_, int N_, int G_, int c_) { nM = M_ / BM; nN = N_ / BM; nwg = nM * nN; G = G_; c = c_; }
    __host__ __device__ bool next(int i, Unit& u) const {
        const long L = (long)i * G + c; if (L >= nwg) return false;
        int wgid = (int)L; { const int q = nwg / NXCD, r = nwg % NXCD, xcd = wgid % NXCD, off = wgid / NXCD; wgid = (xcd < r ? xcd * (q + 1) : r * (q + 1) + (xcd - r) * q) + off; }
        const int nig = WGM * nN, gid = wgid / nig, fm = gid * WGM, gsz = (nM - fm) < WGM ? (nM - fm) : WGM;
        u.pm = fm + ((wgid % nig) % gsz); u.pn = (wgid % nig) / gsz; return true;
    }
    __device__ __forceinline__ void a_ready(const Unit&) const {}
    __device__ __forceinline__ void done(const Unit&) const {}
};

__device__ __forceinline__ unsigned cvt_pk_bf16(float lo, float hi) { unsigned r; asm volatile("v_cvt_pk_bf16_f32 %0, %1, %2" : "=v"(r) : "v"(lo), "v"(hi)); return r; }

template <class Epi, class Sched, bool ALIGN_EPI>
__device__ __forceinline__ void gemm_phase(PG8_LAS unsigned char* lds, const Gemm g, const Sched& S, const Epi& E) {
    const int tid = threadIdx.x, wid = __builtin_amdgcn_readfirstlane(tid >> 6), lane = tid & 63, wr = wid >> 2, wc = wid & 3, fr = lane & 15, fq = lane >> 4;
    int nt = g.K / BK; asm volatile("" : "+s"(nt));
    unsigned voffA[2], voffB[2];
#pragma unroll
    for (int i = 0; i < 2; ++i) { int R, C; stage_rc(tid * 16 + i * 8192, R, C); const int Rb = Epi::PERM ? ((R & ~31) + perm32(R & 31)) : R;
        voffA[i] = (unsigned)(R * g.lda + C) * 2u; voffB[i] = (unsigned)(Rb * g.ldb + C) * 2u; }
    const size_t kstep = (size_t)(BK * 2);
    const size_t hstepA = (size_t)HALF * g.lda * 2, hstepB = (size_t)HALF * g.ldb * 2;
    const size_t tstepA = 2 * hstepA, tstepB = 2 * hstepB;
    const unsigned ldsw = (unsigned)wid * 1024u;
    const int aoff = lds_byte(wr * 64 + fr, fq * 8), boff = lds_byte(wc * 32 + fr, fq * 8);
#define PG8_SA(b, h) (((b) * 2 + (h)) * HTB)
#define PG8_SB(b, h) ((4 + (b) * 2 + (h)) * HTB)
#define PG8_STAGE(bufoff, gbase, voff) do { _Pragma("unroll") for (int _i = 0; _i < 2; ++_i) \
        __builtin_amdgcn_global_load_lds((const unsigned*)((const char*)(gbase) + (voff)[_i]), (PG8_LAS unsigned*)(lds + (bufoff) + ldsw + _i * 8192), 16, 0, 0); } while (0)
#define PG8_LDA(dst, b, h) do { _Pragma("unroll") for (int m = 0; m < 4; ++m) _Pragma("unroll") for (int k = 0; k < 2; ++k) dst[m][k] = *(const PG8_LAS bf16x8*)(lds + PG8_SA(b, h) + aoff + m * 2048 + k * 1024); } while (0)
#define PG8_LDB(dst, b, h) do { _Pragma("unroll") for (int n = 0; n < 2; ++n) _Pragma("unroll") for (int k = 0; k < 2; ++k) dst[n][k] = *(const PG8_LAS bf16x8*)(lds + PG8_SB(b, h) + boff + n * 2048 + k * 1024); } while (0)
#define PG8_MMA(ai, bj, At, Bt) do { __builtin_amdgcn_s_setprio(1); _Pragma("unroll") for (int m = 0; m < 4; ++m) _Pragma("unroll") for (int n = 0; n < 2; ++n) _Pragma("unroll") for (int k = 0; k < 2; ++k) \
        acc[ai][bj][m][n] = __builtin_amdgcn_mfma_f32_16x16x32_bf16(Bt[n][k], At[m][k], acc[ai][bj][m][n], 0, 0, 0); __builtin_amdgcn_s_setprio(0); } while (0)
#define PG8_WAIT_V(n) asm volatile("s_waitcnt vmcnt(" #n ")" ::: "memory")
#define PG8_WAIT_L(n) asm volatile("s_waitcnt lgkmcnt(" #n ")" ::: "memory")
#define PG8_BAR __builtin_amdgcn_s_barrier()
#define PG8_SCHED __builtin_amdgcn_sched_barrier(0)
    Unit cur, nxt; int ui = 0;
    if (!S.next(0, cur)) return;
    f32x4 acc[2][2][4][2];
#pragma unroll
    for (int a = 0; a < 2; ++a)
#pragma unroll
        for (int b = 0; b < 2; ++b)
#pragma unroll
            for (int m = 0; m < 4; ++m)
#pragma unroll
                for (int n = 0; n < 2; ++n) acc[a][b][m][n] = (f32x4){0.f, 0.f, 0.f, 0.f};
    bf16x8 At[4][2], B0[2][2], B1[2][2];
    const char* cA = (const char*)g.A + (size_t)cur.pm * tstepA; const char* cB = (const char*)g.Bt + (size_t)cur.pn * tstepB;
    S.a_ready(cur);
    PG8_STAGE(PG8_SB(0, 0), cB, voffB); PG8_STAGE(PG8_SB(0, 1), cB + hstepB, voffB); PG8_STAGE(PG8_SA(0, 0), cA, voffA); PG8_STAGE(PG8_SA(0, 1), cA + hstepA, voffA);
    if (wr == 1) PG8_BAR;
    PG8_WAIT_V(2); PG8_BAR;
    PG8_STAGE(PG8_SB(1, 0), cB + kstep, voffB); PG8_STAGE(PG8_SA(1, 0), cA + kstep, voffA); PG8_STAGE(PG8_SB(1, 1), cB + hstepB + kstep, voffB);
    PG8_WAIT_V(6); PG8_BAR;
    for (;;) {
        const bool has_next = S.next(ui + 1, nxt);
        const char* nA = has_next ? (const char*)g.A + (size_t)nxt.pm * tstepA : cA; const char* nB = has_next ? (const char*)g.Bt + (size_t)nxt.pn * tstepB : cB;
        for (int t = 0; t < nt; t += 2) {
            const bool last = (t == nt - 2);
            const char* a1 = cA + (size_t)(t + 1) * kstep;
            const char* a2 = last ? nA : cA + (size_t)(t + 2) * kstep; const char* b2 = last ? nB : cB + (size_t)(t + 2) * kstep;
            const char* a3 = a2 + kstep; const char* b3 = b2 + kstep;
            if (last && has_next) S.a_ready(nxt);
            PG8_LDB(B0, 0, 0); PG8_LDB(B1, 0, 1); PG8_SCHED; PG8_LDA(At, 0, 0); PG8_STAGE(PG8_SA(1, 1), a1 + hstepA, voffA);
            PG8_WAIT_V(8); PG8_WAIT_L(0); PG8_BAR; PG8_MMA(0, 0, At, B0); PG8_MMA(0, 1, At, B1); PG8_BAR; PG8_SCHED;
            PG8_LDA(At, 0, 1); PG8_STAGE(PG8_SB(0, 0), b2, voffB); PG8_STAGE(PG8_SB(0, 1), b2 + hstepB, voffB); PG8_STAGE(PG8_SA(0, 0), a2, voffA);
            PG8_WAIT_V(8); PG8_WAIT_L(0); PG8_BAR; PG8_MMA(1, 0, At, B0); PG8_MMA(1, 1, At, B1); PG8_BAR; PG8_SCHED;
            PG8_LDB(B0, 1, 0); PG8_LDB(B1, 1, 1); PG8_SCHED; PG8_LDA(At, 1, 0); PG8_STAGE(PG8_SA(0, 1), a2 + hstepA, voffA);
            PG8_WAIT_V(8); PG8_WAIT_L(0); PG8_BAR; PG8_MMA(0, 0, At, B0); PG8_MMA(0, 1, At, B1); PG8_BAR; PG8_SCHED;
            PG8_LDA(At, 1, 1); PG8_STAGE(PG8_SB(1, 0), b3, voffB); PG8_STAGE(PG8_SB(1, 1), b3 + hstepB, voffB); PG8_STAGE(PG8_SA(1, 0), a3, voffA);
            PG8_WAIT_V(8); PG8_WAIT_L(0); PG8_BAR; PG8_MMA(1, 0, At, B0); PG8_MMA(1, 1, At, B1); PG8_BAR; PG8_SCHED;
        }
        if constexpr (ALIGN_EPI) { if (wr == 0) PG8_BAR; }
        E(acc, cur, wr, wc, fr, fq); S.done(cur);
        if (!has_next) break;
#pragma unroll
        for (int a = 0; a < 2; ++a)
#pragma unroll
            for (int b = 0; b < 2; ++b)
#pragma unroll
                for (int m = 0; m < 4; ++m)
#pragma unroll
                    for (int n = 0; n < 2; ++n) acc[a][b][m][n] = (f32x4){0.f, 0.f, 0.f, 0.f};
        cur = nxt; cA = nA; cB = nB; ++ui;
        if constexpr (ALIGN_EPI) { if (wr == 1) PG8_BAR; }
    }
    PG8_WAIT_V(0);
    if constexpr (!ALIGN_EPI) { if (wr == 0) PG8_BAR; }
    PG8_BAR;
#undef PG8_SA
#undef PG8_SB
#undef PG8_STAGE
#undef PG8_LDA
#undef PG8_LDB
#undef PG8_MMA
#undef PG8_WAIT_V
#undef PG8_WAIT_L
#undef PG8_BAR
#undef PG8_SCHED
}
}

namespace pg8 {
__device__ __forceinline__ float sigm(float x) { return __builtin_amdgcn_rcpf(1.0f + __builtin_amdgcn_exp2f(-1.4426950408889634f * x)); }
__device__ __forceinline__ float silu(float x) { return x * sigm(x); }
__device__ __forceinline__ float bf_lo(unsigned w) { return __uint_as_float(w << 16); }
__device__ __forceinline__ float bf_hi(unsigned w) { return __uint_as_float(w & 0xffff0000u); }
__device__ __forceinline__ u32x4 pack8(const f32x4 a, const f32x4 b) { u32x4 w; w.x = cvt_pk_bf16(a[0], a[1]); w.y = cvt_pk_bf16(a[2], a[3]); w.z = cvt_pk_bf16(b[0], b[1]); w.w = cvt_pk_bf16(b[2], b[3]); return w; }
__device__ __forceinline__ void unpack8(const u32x4 w, f32x4& a, f32x4& b) { a = (f32x4){bf_lo(w.x), bf_hi(w.x), bf_lo(w.y), bf_hi(w.y)}; b = (f32x4){bf_lo(w.z), bf_hi(w.z), bf_lo(w.w), bf_hi(w.w)}; }

struct EpiIn {
    static constexpr bool PERM = true;
    float* U; bf16_t* Qb; float* FG; bf16_t* Vb; bf16_t* SG; bf16_t* GA; bf16_t* GB; const float* rstd; const float* lb;
    __device__ __forceinline__ void operator()(const f32x4 (&acc)[2][2][4][2], const Unit& u, int wr, int wc, int fr, int fq) const {
        const int pn = u.pn, row0 = u.pm * BM + wr * 64 + fr, cl = wc * 32 + 8 * fq;
        int kind, ld, colt; float* df = nullptr; bf16_t* db = nullptr;
        if (pn < 2)       { kind = 0; df = U;  ld = 512;  colt = 256 * pn; }
        else if (pn < 4)  { kind = 3; db = Qb; ld = 512;  colt = 256 * (pn - 2); }
        else if (pn < 6)  { kind = 1; df = FG; ld = 512;  colt = 256 * (pn - 4); }
        else if (pn < 8)  { kind = 2; db = Vb; ld = 512;  colt = 256 * (pn - 6); }
        else if (pn < 10) { kind = 3; db = SG; ld = 512;  colt = 256 * (pn - 8); }
        else if (pn < 14) { kind = 4; db = GA; ld = 1024; colt = 256 * (pn - 10); }
        else              { kind = 4; db = GB; ld = 1024; colt = 256 * (pn - 14); }
        const int c0 = colt + cl;
        f32x4 l0[2], l1[2];
        if (kind == 1) {
#pragma unroll
            for (int bj = 0; bj < 2; ++bj) { l0[bj] = *(const f32x4*)(lb + c0 + bj * HALF); l1[bj] = *(const f32x4*)(lb + c0 + bj * HALF + 4); }
        }
#pragma unroll
        for (int ai = 0; ai < 2; ++ai)
#pragma unroll
            for (int m = 0; m < 4; ++m) {
                const int row = row0 + ai * HALF + m * 16; const float r = rstd[row];
#pragma unroll
                for (int bj = 0; bj < 2; ++bj) {
                    f32x4 v0 = acc[ai][bj][m][0] * r, v1 = acc[ai][bj][m][1] * r;
                    const size_t off = (size_t)row * ld + c0 + bj * HALF;
                    if (kind <= 1) {
                        if (kind == 1) {
#pragma unroll
                            for (int e = 0; e < 4; ++e) { v0[e] = l0[bj][e] + (1.0f - l0[bj][e]) * sigm(v0[e]); v1[e] = l1[bj][e] + (1.0f - l1[bj][e]) * sigm(v1[e]); }
                        }
                        *(f32x4*)(df + off) = v0; *(f32x4*)(df + off + 4) = v1;
                    } else {
                        if (kind == 3) {
#pragma unroll
                            for (int e = 0; e < 4; ++e) { v0[e] = silu(v0[e]); v1[e] = silu(v1[e]); }
                        } else if (kind == 4) {
#pragma unroll
                            for (int e = 0; e < 4; ++e) { v0[e] = sigm(v0[e]); v1[e] = sigm(v1[e]); }
                        }
                        *(u32x4*)(db + off) = pack8(v0, v1);
                    }
                }
            }
    }
};

struct EpiGateA {
    static constexpr bool PERM = true;
    float* T; const bf16_t* GA;
    __device__ __forceinline__ void operator()(const f32x4 (&acc)[2][2][4][2], const Unit& u, int wr, int wc, int fr, int fq) const {
        const int row0 = u.pm * BM + wr * 64 + fr, c0 = u.pn * BM + wc * 32 + 8 * fq;
#pragma unroll
        for (int ai = 0; ai < 2; ++ai)
#pragma unroll
            for (int m = 0; m < 4; ++m) {
                const int row = row0 + ai * HALF + m * 16;
#pragma unroll
                for (int bj = 0; bj < 2; ++bj) {
                    const size_t off = (size_t)row * 1024 + c0 + bj * HALF;
                    f32x4 g0, g1; unpack8(*(const u32x4*)(GA + off), g0, g1);
                    *(f32x4*)(T + off) = acc[ai][bj][m][0] * g0; *(f32x4*)(T + off + 4) = acc[ai][bj][m][1] * g1;
                }
            }
    }
};
struct EpiGateB {
    static constexpr bool PERM = true;
    const float* T; const bf16_t* GB; bf16_t* MG;
    __device__ __forceinline__ void operator()(const f32x4 (&acc)[2][2][4][2], const Unit& u, int wr, int wc, int fr, int fq) const {
        const int row0 = u.pm * BM + wr * 64 + fr, c0 = u.pn * BM + wc * 32 + 8 * fq;
#pragma unroll
        for (int ai = 0; ai < 2; ++ai)
#pragma unroll
            for (int m = 0; m < 4; ++m) {
                const int row = row0 + ai * HALF + m * 16;
#pragma unroll
                for (int bj = 0; bj < 2; ++bj) {
                    const size_t off = (size_t)row * 1024 + c0 + bj * HALF;
                    f32x4 g0, g1; unpack8(*(const u32x4*)(GB + off), g0, g1);
                    const f32x4 t0 = *(const f32x4*)(T + off), t1 = *(const f32x4*)(T + off + 4);
                    *(u32x4*)(MG + off) = pack8(t0 + acc[ai][bj][m][0] * g0, t1 + acc[ai][bj][m][1] * g1);
                }
            }
    }
};
struct EpiRes {
    static constexpr bool PERM = true;
    const float* base_lo; const float* base_hi; float* out; bf16_t* outb; float* ssq;
    __device__ __forceinline__ void operator()(const f32x4 (&acc)[2][2][4][2], const Unit& u, int wr, int wc, int fr, int fq) const {
        const int row0 = u.pm * BM + wr * 64 + fr, c0 = u.pn * BM + wc * 32 + 8 * fq;
        const float* base = (u.pm < 64) ? base_lo : base_hi;
#pragma unroll
        for (int ai = 0; ai < 2; ++ai)
#pragma unroll
            for (int m = 0; m < 4; ++m) {
                const int row = row0 + ai * HALF + m * 16; float s = 0.f;
#pragma unroll
                for (int bj = 0; bj < 2; ++bj) {
                    const size_t off = (size_t)row * 1024 + c0 + bj * HALF;
                    const f32x4 v0 = *(const f32x4*)(base + off) + acc[ai][bj][m][0], v1 = *(const f32x4*)(base + off + 4) + acc[ai][bj][m][1];
                    *(f32x4*)(out + off) = v0; *(f32x4*)(out + off + 4) = v1;
                    *(u32x4*)(outb + off) = pack8(v0, v1);
                    s += (v0[0] * v0[0] + v0[1] * v0[1]) + (v0[2] * v0[2] + v0[3] * v0[3]) + (v1[0] * v1[0] + v1[1] * v1[1]) + (v1[2] * v1[2] + v1[3] * v1[3]);
                }
                s += __shfl_xor(s, 16); s += __shfl_xor(s, 32);
                if (fq == 0) unsafeAtomicAdd(ssq + row, s);
                if (m & 1) asm volatile("" ::: "memory");
            }
    }
};
struct EpiSwiGLU {
    static constexpr bool PERM = true;
    bf16_t* ACT; const float* ssq;
    __device__ __forceinline__ void operator()(const f32x4 (&acc)[2][2][4][2], const Unit& u, int wr, int wc, int fr, int fq) const {
        const int row0 = u.pm * BM + wr * 64 + fr, c0 = u.pn * HALF + wc * 32 + 8 * fq;
#pragma unroll
        for (int ai = 0; ai < 2; ++ai)
#pragma unroll
            for (int m = 0; m < 4; ++m) {
                const int row = row0 + ai * HALF + m * 16; const float r = __builtin_amdgcn_rsqf(ssq[row] * (1.0f / 1024.0f) + EPS);
                f32x4 a0 = acc[ai][0][m][0] * r, a1 = acc[ai][0][m][1] * r; const f32x4 u0 = acc[ai][1][m][0] * r, u1 = acc[ai][1][m][1] * r;
#pragma unroll
                for (int e = 0; e < 4; ++e) { a0[e] = silu(a0[e]) * u0[e]; a1[e] = silu(a1[e]) * u1[e]; }
                *(u32x4*)(ACT + (size_t)row * FF + c0) = pack8(a0, a1);
            }
    }
};
struct EpiBf {
    static constexpr bool PERM = true;
    bf16_t* O;
    __device__ __forceinline__ void operator()(const f32x4 (&acc)[2][2][4][2], const Unit& u, int wr, int wc, int fr, int fq) const {
        const int row0 = u.pm * BM + wr * 64 + fr, c0 = u.pn * BM + wc * 32 + 8 * fq;
#pragma unroll
        for (int ai = 0; ai < 2; ++ai)
#pragma unroll
            for (int m = 0; m < 4; ++m) {
                const int row = row0 + ai * HALF + m * 16;
#pragma unroll
                for (int bj = 0; bj < 2; ++bj) *(u32x4*)(O + (size_t)row * 1024 + c0 + bj * HALF) = pack8(acc[ai][bj][m][0], acc[ai][bj][m][1]);
            }
    }
};
struct EpiPle {
    static constexpr bool PERM = true;
    float* X; const bf16_t* EMB; const float* ssq_in; float* ssq_out;
    __device__ __forceinline__ void operator()(const f32x4 (&acc)[2][2][4][2], const Unit& u, int wr, int wc, int fr, int fq) const {
        const int row0 = u.pm * BM + wr * 64 + fr, c0 = u.pn * BM + wc * 32 + 8 * fq;
#pragma unroll
        for (int ai = 0; ai < 2; ++ai)
#pragma unroll
            for (int m = 0; m < 4; ++m) {
                const int row = row0 + ai * HALF + m * 16; const float r = __builtin_amdgcn_rsqf(ssq_in[row] * (1.0f / 1024.0f) + EPS); float s = 0.f;
#pragma unroll
                for (int bj = 0; bj < 2; ++bj) {
                    const size_t off = (size_t)row * 1024 + c0 + bj * HALF;
                    f32x4 e0, e1; unpack8(*(const u32x4*)(EMB + off), e0, e1);
                    f32x4 v0 = *(const f32x4*)(X + off), v1 = *(const f32x4*)(X + off + 4);
#pragma unroll
                    for (int e = 0; e < 4; ++e) { v0[e] += sigm(acc[ai][bj][m][0][e] * r) * e0[e]; v1[e] += sigm(acc[ai][bj][m][1][e] * r) * e1[e]; }
                    *(f32x4*)(X + off) = v0; *(f32x4*)(X + off + 4) = v1;
                    s += (v0[0] * v0[0] + v0[1] * v0[1]) + (v0[2] * v0[2] + v0[3] * v0[3]) + (v1[0] * v1[0] + v1[1] * v1[1]) + (v1[2] * v1[2] + v1[3] * v1[3]);
                }
                s += __shfl_xor(s, 16); s += __shfl_xor(s, 32);
                if (fq == 0) unsafeAtomicAdd(ssq_out + row, s);
                if (m & 1) asm volatile("" ::: "memory");
            }
    }
};
}

constexpr int NWAVES = 8;
constexpr size_t MiB = 1u << 20;
constexpr size_t WS_CTL = 0, CTL_ZERO_BYTES = 1 * MiB;
constexpr size_t WS_SMALL = 1 * MiB;
constexpr size_t SM_LB = 0, SM_RSTD0 = 4096, SM_SSQ1 = SM_RSTD0 + 69632 * 1, SM_SSQ2 = SM_SSQ1 + 69632, SM_SSQ3 = SM_SSQ2 + 69632;
constexpr size_t WS_WIN = 2 * MiB;
constexpr size_t WS_WAB = 11 * MiB;
constexpr size_t WS_WOUT = 13 * MiB;
constexpr size_t WS_WGU = 15 * MiB;
constexpr size_t WS_WDN = 26 * MiB;
constexpr size_t WS_WPG = 32 * MiB;
constexpr size_t WS_WPP = 34 * MiB;
constexpr size_t WS_PB = 35 * MiB;
constexpr size_t WS_XB = 44 * MiB;
constexpr size_t WS_QB = 78 * MiB;
constexpr size_t WS_VB = 95 * MiB;
constexpr size_t WS_SG = 112 * MiB;
constexpr size_t WS_GA = 129 * MiB;
constexpr size_t WS_GB = 163 * MiB;
constexpr size_t WS_O = 197 * MiB;
constexpr size_t WS_ACT = 78 * MiB;
constexpr size_t WS_END = 232 * MiB;
static_assert(WS_ACT + (size_t)M * FF * 2 <= WS_O, "act overlay");
static_assert(WS_WDN + (size_t)D * FF * 2 <= WS_WPG && WS_WPP + (size_t)D * PD * 2 <= WS_PB && WS_PB + (size_t)M * PD * 2 <= WS_XB && WS_XB + (size_t)M * D * 2 <= WS_QB, "ws map");
static_assert(WS_GB + (size_t)M * D * 2 <= WS_O && WS_O + (size_t)M * PW * 4 <= WS_END, "ws map 2");
constexpr size_t OUT_Y = 0, OUT_NPP = (size_t)M * D, OUT_NHP = OUT_NPP + (size_t)NB * PBUF * PW, OUT_NPS = OUT_NHP + (size_t)NB * NH * DK * DV, OUT_NHS = OUT_NPS + (size_t)DB * PBUF * PW,
                 OUT_END = OUT_NHS + (size_t)DB * NH * DK * DV;

constexpr int RING_BYTES = 131072, MISC_OFF = RING_BYTES, LDS_BYTES = 147456;

#define LAS __attribute__((address_space(3)))
typedef unsigned short bf16;
typedef unsigned v4u __attribute__((ext_vector_type(4)));
typedef unsigned v2u __attribute__((ext_vector_type(2)));
typedef float f32x4 __attribute__((ext_vector_type(4)));
#define LDS_WAIT() asm volatile("s_waitcnt lgkmcnt(0)" ::: "memory")
__device__ __forceinline__ unsigned pk2(float lo, float hi) { return pg8::cvt_pk_bf16(lo, hi); }
__device__ __forceinline__ float bf2f(bf16 v) { return __uint_as_float((unsigned)v << 16); }
__device__ __forceinline__ float wave_sum(float v) {
#pragma unroll
    for (int o = 1; o < 64; o <<= 1) v += __shfl_xor(v, o);
    return v;
}

#define XB_TMO      128
#define XB_XCNT(j)  (256  + 64 * (j))
#define XB_XSUB(j)  (1280 + 64 * (j))
#define XB_XGEN(j)  (2304 + 64 * (j))
#define XB_TOP      3328
#define XB_TOPGEN   3392
#define XCD_BAR_WORDS 3456
#define XB_SPIN_CAP (1u << 18)

__device__ __forceinline__ unsigned xb_ld(unsigned* p)              { return __hip_atomic_load(p, __ATOMIC_RELAXED, __HIP_MEMORY_SCOPE_AGENT); }
__device__ __forceinline__ unsigned xb_add(unsigned* p, unsigned v) { return __hip_atomic_fetch_add(p, v, __ATOMIC_RELAXED, __HIP_MEMORY_SCOPE_AGENT); }
__device__ __forceinline__ unsigned xb_xcc_id() { return (unsigned)__builtin_amdgcn_s_getreg((3 << 11) | 20) & 0xFu; }
#define XB_SPIN(cond, bar) do { unsigned _sp = 0; while (cond) { __builtin_amdgcn_s_sleep(1); \
    if ((++_sp & 255u) == 0u) { if (xb_ld(&(bar)[XB_TMO])) break; if (_sp > XB_SPIN_CAP) { atomicAdd(&(bar)[XB_TMO], 1u); break; } } } } while (0)

struct XcdBarrier {
    unsigned* bar; unsigned x;
    volatile LAS unsigned* st;
};

__device__ __forceinline__ XcdBarrier xcd_barrier_post(unsigned* bar, volatile LAS unsigned* st) {
    XcdBarrier b; b.bar = bar; b.x = xb_xcc_id(); b.st = st;
    if (threadIdx.x == 0) (void)xb_add(&bar[XB_XCNT(b.x)], 1u);
    return b;
}
__device__ __forceinline__ void xcd_barrier_complete(unsigned* bar, unsigned x, unsigned& nloc, unsigned& nx) {
    const unsigned G = gridDim.x * gridDim.y * gridDim.z;
    unsigned sum, cnt, mine, sp = 0u;
    for (;;) {
        sum = 0u; cnt = 0u; mine = 0u;
#pragma unroll
        for (unsigned j = 0; j < 16; ++j) { const unsigned c = xb_ld(&bar[XB_XCNT(j)]); sum += c; cnt += (c > 0u) ? 1u : 0u; mine = (j == x) ? c : mine; }
        if (sum == G) break;
        __builtin_amdgcn_s_sleep(1);
        if ((++sp & 255u) == 0u) { if (xb_ld(&bar[XB_TMO])) break; if (sp > XB_SPIN_CAP) { atomicAdd(&bar[XB_TMO], 1u); break; } }
    }
    nloc = mine > 0u ? mine : 1u; nx = cnt > 0u ? cnt : 1u;
}

__device__ __forceinline__ void xcd_barrier(const XcdBarrier& b) {
    asm volatile("s_waitcnt vmcnt(0)" ::: "memory");
    __syncthreads();
    if (threadIdx.x == 0) {
        unsigned* bar = b.bar;
        __builtin_amdgcn_s_waitcnt(0);
        unsigned nloc = b.st[0], nx = b.st[1];
        if (nloc == 0u) { xcd_barrier_complete(bar, b.x, nloc, nx); b.st[0] = nloc; b.st[1] = nx; }
        const unsigned old = xb_add(&bar[XB_XSUB(b.x)], 1u);
        const unsigned gen = old / nloc;
        if (old + 1u == (gen + 1u) * nloc) {
            __builtin_amdgcn_fence(__ATOMIC_RELEASE, "agent");
            asm volatile("s_waitcnt vmcnt(0)" ::: "memory");
            const unsigned og = xb_add(&bar[XB_TOP], 1u);
            const unsigned tg = og / nx;
            if (og + 1u == (tg + 1u) * nx) xb_add(&bar[XB_TOPGEN], 1u);
            else XB_SPIN(xb_ld(&bar[XB_TOPGEN]) == tg, bar);
            __builtin_amdgcn_fence(__ATOMIC_ACQUIRE, "agent");
            xb_add(&bar[XB_XGEN(b.x)], 1u);
            asm volatile("s_waitcnt vmcnt(0)" ::: "memory");
        } else {
            XB_SPIN(xb_ld(&bar[XB_XGEN(b.x)]) == gen, bar);
            __builtin_amdgcn_fence(__ATOMIC_ACQUIRE, "agent");
            asm volatile("s_waitcnt vmcnt(0)" ::: "memory");
        }
    }
    __syncthreads();
}

struct Frame {
    LAS unsigned char* lds;
    int tid, lane, wave, G, wg;
    float* out; unsigned char* ws;
};
struct Args { const float* in[23]; float* out; unsigned char* ws; unsigned long long prog; };
static_assert(sizeof(Args) == 23 * 8 + 8 + 8 + 8, "Args has no padding");
enum { I_XP = 0, I_XS, I_SPOOL, I_SHGRN, I_PP, I_PS, I_GMIX, I_WIN, I_WPMIX, I_PSCALE, I_HLB, I_HNORM, I_WPUP, I_WHUP, I_WOUT, I_GFFN, I_WFG, I_WFU, I_WFD, I_GPLE, I_WPG, I_WPPJ, I_GFIN };

__device__ __forceinline__ void p0_transpose_item(const float* W, int N, const float* gain, bf16* WT, int ldk, int drow, int k0, int n0, int koff, LAS float* scr, int lane) {
#pragma unroll 8
    for (int i = 0; i < 32; ++i) { const int kk = 2 * i + (lane >> 5); float v = W[(size_t)(k0 + kk) * N + n0 + (lane & 31)]; if (gain) v *= gain[k0 + kk]; scr[kk * 33 + (lane & 31)] = v; }
    LDS_WAIT(); asm volatile("" ::: "memory");
    const int c = lane & 7;
#pragma unroll
    for (int j = 0; j < 4; ++j) { const int n = (lane >> 3) + 8 * j; const LAS float* s = scr + (8 * c) * 33 + n;
        v4u o; o.x = pk2(s[0 * 33], s[1 * 33]); o.y = pk2(s[2 * 33], s[3 * 33]); o.z = pk2(s[4 * 33], s[5 * 33]); o.w = pk2(s[6 * 33], s[7 * 33]);
        *(v4u*)(WT + (size_t)(drow + n) * ldk + koff + k0 + 8 * c) = o; }
    LDS_WAIT(); asm volatile("" ::: "memory");
}
__device__ __forceinline__ void p0_fold_item(const float* w_pool_mix, const float* w_pool_up, const float* pool_scale, bf16* WAB, int item, int lane) {
    const int g = item >> 7, cb = (item >> 4) & 7, nb = item & 15, n = nb * 64 + lane, c0 = cb * 16;
    float a[16];
#pragma unroll
    for (int c = 0; c < 16; ++c) a[c] = 0.f;
    const float* mix = w_pool_mix + (size_t)g * 128 * 128 + (size_t)c0 * 128;
    for (int d = 0; d < 128; ++d) {
        const float w = w_pool_up[(size_t)(g * 128 + d) * D + n] * pool_scale[g * 128 + d];
#pragma unroll
        for (int c = 0; c < 16; ++c) a[c] += mix[c * 128 + d] * w;
    }
    v4u o0, o1; o0.x = pk2(a[0], a[1]); o0.y = pk2(a[2], a[3]); o0.z = pk2(a[4], a[5]); o0.w = pk2(a[6], a[7]); o1.x = pk2(a[8], a[9]); o1.y = pk2(a[10], a[11]); o1.z = pk2(a[12], a[13]); o1.w = pk2(a[14], a[15]);
    bf16* dst = WAB + (size_t)n * 1024 + g * 128 + c0; *(v4u*)dst = o0; *(v4u*)(dst + 8) = o1;
}
__device__ __forceinline__ void p0_prologue(const Frame& F, const Args& A) {
    LAS float* scr = (LAS float*)(F.lds + F.wave * 16384);
    const int gw = F.wg * NWAVES + F.wave, NGW = F.G * NWAVES, lane = F.lane;
    unsigned char* ws = F.ws;
    bf16 *WIN = (bf16*)(ws + WS_WIN), *WAB = (bf16*)(ws + WS_WAB), *WOUT = (bf16*)(ws + WS_WOUT), *WGU = (bf16*)(ws + WS_WGU), *WDN = (bf16*)(ws + WS_WDN), *WPG = (bf16*)(ws + WS_WPG), *WPP = (bf16*)(ws + WS_WPP);
    constexpr int NI_IN = 16 * 144, NI_HU = 8 * 32, NI_OUT = 16 * 32, NI_G = 16 * 88, NI_DN = 44 * 32, NI_PG = 16 * 32, NI_PP = 4 * 32, NI_FOLD = 512;
    constexpr int NITEMS = NI_IN + NI_HU + NI_OUT + 2 * NI_G + NI_DN + NI_PG + NI_PP + NI_FOLD;
    for (int it = gw; it < NITEMS; it += NGW) {
        int r = it;
        if (r < NI_IN) { const int kb = r / 144, nb = r % 144; p0_transpose_item(A.in[I_WIN], NIN, A.in[I_GMIX], WIN, 1024, 32 * nb, 64 * kb, 32 * nb, 0, scr, lane); continue; } r -= NI_IN;
        if (r < NI_HU) { const int kb = r / 32, nb = r % 32; p0_transpose_item(A.in[I_WHUP], D, nullptr, WAB, 1024, 32 * nb, 64 * kb, 32 * nb, 512, scr, lane); continue; } r -= NI_HU;
        if (r < NI_OUT) { const int kb = r / 32, nb = r % 32; p0_transpose_item(A.in[I_WOUT], D, nullptr, WOUT, 1024, 32 * nb, 64 * kb, 32 * nb, 0, scr, lane); continue; } r -= NI_OUT;
        if (r < NI_G) { const int kb = r / 88, nb = r % 88, n0 = 32 * nb; p0_transpose_item(A.in[I_WFG], FF, A.in[I_GFFN], WGU, 1024, (n0 >> 7) * 256 + (n0 & 127), 64 * kb, n0, 0, scr, lane); continue; } r -= NI_G;
        if (r < NI_G) { const int kb = r / 88, nb = r % 88, n0 = 32 * nb; p0_transpose_item(A.in[I_WFU], FF, A.in[I_GFFN], WGU, 1024, (n0 >> 7) * 256 + 128 + (n0 & 127), 64 * kb, n0, 0, scr, lane); continue; } r -= NI_G;
        if (r < NI_DN) { const int kb = r / 32, nb = r % 32; p0_transpose_item(A.in[I_WFD], D, nullptr, WDN, FF, 32 * nb, 64 * kb, 32 * nb, 0, scr, lane); continue; } r -= NI_DN;
        if (r < NI_PG) { const int kb = r / 32, nb = r % 32; p0_transpose_item(A.in[I_WPG], D, A.in[I_GPLE], WPG, 1024, 32 * nb, 64 * kb, 32 * nb, 0, scr, lane); continue; } r -= NI_PG;
        if (r < NI_PP) { const int kb = r / 32, nb = r % 32; p0_transpose_item(A.in[I_WPPJ], D, nullptr, WPP, 256, 32 * nb, 64 * kb, 32 * nb, 0, scr, lane); continue; } r -= NI_PP;
        p0_fold_item(A.in[I_WPMIX], A.in[I_WPUP], A.in[I_PSCALE], WAB, r, lane);
    }
    bf16* XB = (bf16*)(ws + WS_XB); bf16* PB = (bf16*)(ws + WS_PB);
    float* small = (float*)(ws + WS_SMALL);
    float* RSTD0 = (float*)((char*)small + SM_RSTD0); float* SSQ1 = (float*)((char*)small + SM_SSQ1);
    for (int m = gw; m < M; m += NGW) {
        const float* xrow = (m < MP) ? A.in[I_XP] + (size_t)m * D : A.in[I_XS] + (size_t)(m - MP) * D;
        const f32x4* xr = (const f32x4*)xrow + lane; f32x4 v[4]; float s = 0.f;
#pragma unroll
        for (int j = 0; j < 4; ++j) { v[j] = xr[64 * j]; s += (v[j].x * v[j].x + v[j].y * v[j].y) + (v[j].z * v[j].z + v[j].w * v[j].w); }
        s = wave_sum(s);
        v2u* o8 = (v2u*)(XB + (size_t)m * D) + lane;
#pragma unroll
        for (int j = 0; j < 4; ++j) { v2u w; w.x = pk2(v[j].x, v[j].y); w.y = pk2(v[j].z, v[j].w); o8[64 * j] = w; }
        const float* prow = (m < MP) ? A.in[I_PP] + (size_t)m * PD : A.in[I_PS] + (size_t)(m - MP) * PD;
        const f32x4 pv = ((const f32x4*)prow)[lane]; v2u pw; pw.x = pk2(pv.x, pv.y); pw.y = pk2(pv.z, pv.w); ((v2u*)(PB + (size_t)m * PD))[lane] = pw;
        if (lane == 0) { RSTD0[m] = 1.0f / sqrtf(s * (1.0f / D) + EPS); }
        if (lane < 3) SSQ1[lane * M + m] = 0.f;
    }
    if (F.wg == 0) { float* LB = (float*)((char*)small + SM_LB); const int c = F.tid; if (c < 512) { const float a0 = A.in[I_HLB][c], a1 = A.in[I_HLB][512 + c]; LB[c] = 1.0f / (1.0f + expf(a1 - a0)); } }
}

__device__ __forceinline__ void p2_pool(const Frame& F, const Args& A) {
    const float* U = F.out + OUT_Y; bf16* AB = (bf16*)(F.ws + WS_XB);
    const int gt = F.wg * (NWAVES * 64) + F.tid, NT = F.G * NWAVES * 64;
    for (int idx = gt; idx < M * PW; idx += NT) {
        const int m = idx >> 9, c = idx & 511, g = c >> 7, w = 2 << g; float s = 0.f; int cnt;
        if (m < MP) { const int t = m & (SEQ - 1); cnt = (t + 1 < w) ? t + 1 : w; for (int j = 0; j < cnt; ++j) s += U[(size_t)(m - j) * PW + c]; }
        else { const int ms = m - MP, b = ms >> 3, t = ms & 7; cnt = w;
            for (int j = 0; j < w; ++j) s += (t - j >= 0) ? U[(size_t)(m - j) * PW + c] : A.in[I_SPOOL][((size_t)b * PBUF + (PBUF + t - j)) * PW + c]; }
        const float pooled = s / (float)cnt - U[(size_t)m * PW + c];
        AB[(size_t)m * 1024 + c] = (bf16)(pk2(pooled, 0.f) & 0xffffu);
    }
    float* NPP = F.out + OUT_NPP; float* NPS = F.out + OUT_NPS;
    for (int idx = gt; idx < NB * PBUF * PW; idx += NT) { const int c = idx & 511, i = (idx >> 9) % PBUF, b = (idx >> 9) / PBUF; NPP[idx] = U[((size_t)b * SEQ + SEQ - PBUF + i) * PW + c]; }
    for (int idx = gt; idx < DB * PBUF * PW; idx += NT) { const int c = idx & 511, i = (idx >> 9) % PBUF, b = (idx >> 9) / PBUF;
        NPS[idx] = (i < 7) ? A.in[I_SPOOL][((size_t)b * PBUF + 8 + i) * PW + c] : U[((size_t)MP + b * DS + (i - 7)) * PW + c]; }
}

__device__ __forceinline__ void p2_rec_item(const Frame& F, const Args& A, int item) {
    const float* FG = F.out + OUT_Y + (size_t)M * PW; const bf16* QB = (const bf16*)(F.ws + WS_QB); const bf16* VB = (const bf16*)(F.ws + WS_VB); float* O = (float*)(F.ws + WS_O);
    LAS float* Fs = (LAS float*)(F.lds); LAS float* Qs = Fs + 32 * 128; LAS float* Vs = Qs + 32 * 128; LAS float* Os = Vs + 32 * 64;
    const int tid = F.tid, vi = tid >> 3, kg = tid & 7;
    int T, row0, h, vh; const float* s0 = nullptr; float* sout;
    if (item < 64) { const int bh = item >> 1; vh = item & 1; const int b = bh >> 2; h = bh & 3; T = SEQ; row0 = b * SEQ; sout = F.out + OUT_NHP + (size_t)bh * DK * DV; }
    else { const int it = item - 64, bh = it >> 1; vh = it & 1; const int b = bh >> 2; h = bh & 3; T = DS; row0 = MP + b * DS; s0 = A.in[I_SHGRN] + (size_t)bh * DK * DV; sout = F.out + OUT_NHS + (size_t)bh * DK * DV; }
    float S[16];
#pragma unroll
    for (int i = 0; i < 16; ++i) S[i] = s0 ? s0[(size_t)(kg * 16 + i) * DV + vh * 64 + vi] : 0.f;
    for (int t0 = 0; t0 < T; t0 += 32) {
        const int nt = (T - t0 < 32) ? T - t0 : 32;
        for (int idx = tid; idx < nt * 128; idx += 512) { const int tt = idx >> 7, k = idx & 127; const size_t g = (size_t)(row0 + t0 + tt) * HW + h * 128 + k; Fs[idx] = FG[g]; Qs[idx] = bf2f(QB[g]); }
        for (int idx = tid; idx < nt * 64; idx += 512) { const int tt = idx >> 6, v = idx & 63; Vs[idx] = bf2f(VB[(size_t)(row0 + t0 + tt) * HW + h * 128 + vh * 64 + v]); }
        __syncthreads();
        for (int tt = 0; tt < nt; ++tt) {
            const float v = Vs[tt * 64 + vi]; float a = 0.f;
            const LAS f32x4* fp = (const LAS f32x4*)(Fs + tt * 128 + kg * 16); const LAS f32x4* qp = (const LAS f32x4*)(Qs + tt * 128 + kg * 16);
#pragma unroll
            for (int i4 = 0; i4 < 4; ++i4) { const f32x4 f = fp[i4], q = qp[i4];
#pragma unroll
                for (int e = 0; e < 4; ++e) { const int i = i4 * 4 + e; S[i] = f[e] * S[i] + (1.0f - f[e]) * v; a += S[i] * q[e]; } }
            a += __shfl_xor(a, 1); a += __shfl_xor(a, 2); a += __shfl_xor(a, 4);
            if (kg == 0) Os[tt * 64 + vi] = a;
        }
        __syncthreads();
        for (int idx = tid; idx < nt * 64; idx += 512) { const int tt = idx >> 6, v = idx & 63; O[(size_t)(row0 + t0 + tt) * HW + h * 128 + vh * 64 + v] = Os[idx]; }
    }
#pragma unroll
    for (int i = 0; i < 16; ++i) sout[(size_t)(kg * 16 + i) * DV + vh * 64 + vi] = S[i];
    __syncthreads();
}
__device__ __forceinline__ void p2_onorm(const Frame& F, const Args& A) {
    const float* O = (const float*)(F.ws + WS_O); const bf16* SG = (const bf16*)(F.ws + WS_SG); bf16* AB = (bf16*)(F.ws + WS_XB);
    const int gw = F.wg * NWAVES + F.wave, NGW = F.G * NWAVES, lane = F.lane;
    for (int m = gw; m < M; m += NGW) {
        const f32x4 a = *(const f32x4*)(O + (size_t)m * HW + lane * 8), b = *(const f32x4*)(O + (size_t)m * HW + lane * 8 + 4);
        float s = (a.x * a.x + a.y * a.y) + (a.z * a.z + a.w * a.w) + (b.x * b.x + b.y * b.y) + (b.z * b.z + b.w * b.w);
        s += __shfl_xor(s, 1); s += __shfl_xor(s, 2); s += __shfl_xor(s, 4); s += __shfl_xor(s, 8);
        const float r = 1.0f / sqrtf(s * (1.0f / DV) + EPS);
        const f32x4 n0 = *(const f32x4*)(A.in[I_HNORM] + lane * 8), n1 = *(const f32x4*)(A.in[I_HNORM] + lane * 8 + 4);
        const v4u gw4 = *(const v4u*)(SG + (size_t)m * HW + lane * 8); f32x4 g0, g1; pg8::unpack8(gw4, g0, g1);
        *(v4u*)(AB + (size_t)m * 1024 + 512 + lane * 8) = pg8::pack8(a * r * n0 * g0, b * r * n1 * g1);
    }
}
__device__ __forceinline__ void p_final(const Frame& F, const Args& A) {
    float* Y = F.out + OUT_Y; const float* SSQ3 = (const float*)(F.ws + WS_SMALL + SM_SSQ3);
    const int gw = F.wg * NWAVES + F.wave, NGW = F.G * NWAVES, lane = F.lane;
    f32x4 gf[4];
#pragma unroll
    for (int j = 0; j < 4; ++j) gf[j] = ((const f32x4*)A.in[I_GFIN])[lane + 64 * j];
    for (int m = gw; m < M; m += NGW) {
        const float r = 1.0f / sqrtf(SSQ3[m] * (1.0f / D) + EPS);
        f32x4* yr = (f32x4*)(Y + (size_t)m * D) + lane;
#pragma unroll
        for (int j = 0; j < 4; ++j) yr[64 * j] = yr[64 * j] * r * gf[j];
    }
}

#ifndef MK_N_LAUNCHES
#define MK_N_LAUNCHES 1
#endif
constexpr int N_PHASES = 12;
#ifndef PROG
#define PROG 0xfffull
#endif

__global__ void __launch_bounds__(NWAVES * 64, 2) fwd_kernel(Args args) {
    extern __shared__ __attribute__((aligned(16))) unsigned char lds_raw[];
    Frame F;
    F.lds = (LAS unsigned char*)lds_raw;
    F.tid = threadIdx.x; F.lane = F.tid & 63; F.wave = __builtin_amdgcn_readfirstlane(F.tid >> 6);
    F.G = gridDim.x; F.wg = blockIdx.x;
    F.out = args.out; F.ws = args.ws;
    unsigned char* ws = args.ws;
    using namespace pg8;
    float* small = (float*)(ws + WS_SMALL);
    float* LB = (float*)((char*)small + SM_LB); float* RSTD0 = (float*)((char*)small + SM_RSTD0);
    float* SSQ1 = (float*)((char*)small + SM_SSQ1); float* SSQ2 = (float*)((char*)small + SM_SSQ2); float* SSQ3 = (float*)((char*)small + SM_SSQ3);
    bf16_t *WIN = (bf16_t*)(ws + WS_WIN), *WAB = (bf16_t*)(ws + WS_WAB), *WOUT = (bf16_t*)(ws + WS_WOUT), *WGU = (bf16_t*)(ws + WS_WGU), *WDN = (bf16_t*)(ws + WS_WDN), *WPG = (bf16_t*)(ws + WS_WPG), *WPP = (bf16_t*)(ws + WS_WPP);
    bf16_t *PB = (bf16_t*)(ws + WS_PB), *XB = (bf16_t*)(ws + WS_XB), *QB = (bf16_t*)(ws + WS_QB), *VB = (bf16_t*)(ws + WS_VB), *SG = (bf16_t*)(ws + WS_SG), *GA = (bf16_t*)(ws + WS_GA), *GB = (bf16_t*)(ws + WS_GB);
    bf16_t *MG = (bf16_t*)(ws + WS_O), *EMB = (bf16_t*)(ws + WS_O), *ACT = (bf16_t*)(ws + WS_ACT);
    float* Y = F.out + OUT_Y; float* U = Y; float* FGp = Y + (size_t)M * PW; float* T = Y;
    const int c = (int)blockIdx.x;

#define IN(k) ((pmask >> (k)) & 1u)
#define SEAM(k) do { if (IN(k) && (pmask >> ((k) + 1))) { xcd_barrier(bar); } } while (0)
#ifndef PROBE_DUP
#define PROBE_DUP 0x0
#endif
#define DUP(k) ((PROBE_DUP >> (k)) & 1)
    const unsigned pmask = (unsigned)args.prog;
    for (int u = F.tid; u < (LDS_BYTES - MISC_OFF) / 4; u += NWAVES * 64) ((LAS unsigned*)(F.lds + MISC_OFF))[u] = 0u;
    __syncthreads();
    XcdBarrier bar = xcd_barrier_post((unsigned*)(ws + WS_CTL), (volatile LAS unsigned*)(F.lds + MISC_OFF) + 8);
    if (pmask & 0x80000000u) cg::this_grid().sync();
#define PH0 { p0_prologue(F, args); }
#define PH1 { Gemm g{XB, WIN, M, NIN, D, D, D}; StaticOrder S; S.init(M, NIN, F.G, c); EpiIn E{U, QB, FGp, VB, SG, GA, GB, RSTD0, LB}; gemm_phase<EpiIn, StaticOrder, true>(F.lds, g, S, E); }
#define PH2 { p2_pool(F, args); for (int it = F.wg; it < 64 + 1024; it += F.G) p2_rec_item(F, args, it); }
#define PH3 { p2_onorm(F, args); }
#define PH4 { Gemm g{XB, WAB, M, D, 512, D, D}; StaticOrder S; S.init(M, D, F.G, c); EpiGateA E{T, GA}; gemm_phase<EpiGateA, StaticOrder, true>(F.lds, g, S, E); }
#define PH5 { Gemm g{XB + 512, WAB + 512, M, D, 512, D, D}; StaticOrder S; S.init(M, D, F.G, c); EpiGateB E{T, GB, MG}; gemm_phase<EpiGateB, StaticOrder, true>(F.lds, g, S, E); }
#define PH6 { Gemm g{MG, WOUT, M, D, D, D, D}; StaticOrder S; S.init(M, D, F.G, c); EpiRes E{args.in[I_XP], args.in[I_XS] - (size_t)MP * D, Y, XB, SSQ1}; gemm_phase<EpiRes, StaticOrder, true>(F.lds, g, S, E); }
#define PH7 { Gemm g{XB, WGU, M, 2 * FF, D, D, D}; StaticOrder S; S.init(M, 2 * FF, F.G, c); EpiSwiGLU E{ACT, SSQ1}; gemm_phase<EpiSwiGLU, StaticOrder, true>(F.lds, g, S, E); }
#define PH8 { Gemm g{ACT, WDN, M, D, FF, FF, FF}; StaticOrder S; S.init(M, D, F.G, c); EpiRes E{Y, Y, Y, XB, SSQ2}; gemm_phase<EpiRes, StaticOrder, true>(F.lds, g, S, E); }
#define PH9 { Gemm g{PB, WPP, M, D, PD, PD, PD}; StaticOrder S; S.init(M, D, F.G, c); EpiBf E{EMB}; gemm_phase<EpiBf, StaticOrder, true>(F.lds, g, S, E); }
#define PH10 { Gemm g{XB, WPG, M, D, D, D, D}; StaticOrder S; S.init(M, D, F.G, c); EpiPle E{Y, EMB, SSQ2, SSQ3}; gemm_phase<EpiPle, StaticOrder, true>(F.lds, g, S, E); }
#define PH11 { p_final(F, args); }
#define RUN(k, BODY) if (IN(k)) { BODY if (DUP(k)) { xcd_barrier(bar); BODY } } SEAM(k);
    RUN(0, PH0) RUN(1, PH1) RUN(2, PH2) RUN(3, PH3) RUN(4, PH4) RUN(5, PH5) RUN(6, PH6) RUN(7, PH7) RUN(8, PH8) RUN(9, PH9) RUN(10, PH10) RUN(11, PH11)
}

extern "C" void kernel_launch(void* const* d_in, const int* in_sizes, int n_in, void* d_out, int out_size, void* d_ws, size_t ws_size, hipStream_t stream) {
    static int grid = 0;
    if (grid == 0) {
        if (n_in != 23 || in_sizes[0] != MP * D || (size_t)out_size != OUT_END || ws_size < WS_END) { fprintf(stderr, "kernel_launch: unexpected shapes (n_in %d, in0 %d, out %d, ws %zu)\n", n_in, n_in > 0 ? in_sizes[0] : -1, out_size, ws_size); grid = -1; return; }
        int dev = 0, cus = 0, per_cu = 0;
        if (hipGetDevice(&dev) != hipSuccess || hipDeviceGetAttribute(&cus, hipDeviceAttributeMultiprocessorCount, dev) != hipSuccess) { grid = -1; return; }
        if (hipFuncSetAttribute((const void*)fwd_kernel, hipFuncAttributeMaxDynamicSharedMemorySize, LDS_BYTES) != hipSuccess) { fprintf(stderr, "kernel_launch: hipFuncSetAttribute failed\n"); grid = -1; return; }
        if (hipOccupancyMaxActiveBlocksPerMultiprocessor(&per_cu, (const void*)fwd_kernel, NWAVES * 64, LDS_BYTES) != hipSuccess || per_cu < 1) { fprintf(stderr, "kernel_launch: occupancy query says %d blocks per CU\n", per_cu); (void)hipGetLastError(); grid = -1; return; }
        grid = cus * per_cu;
    }
    if (grid < 0) return;
    (void)hipMemsetAsync((char*)d_ws + WS_CTL, 0, 65536, stream);
    Args a{};
    for (int i = 0; i < 23; ++i) a.in[i] = (const float*)d_in[i];
    a.out = (float*)d_out; a.ws = (unsigned char*)d_ws;
#if MK_N_LAUNCHES == 1
    a.prog = PROG;
    void* kargs[] = {&a};
    hipError_t e = hipLaunchCooperativeKernel((const void*)fwd_kernel, dim3(grid), dim3(NWAVES * 64), kargs, LDS_BYTES, stream);
    if (e != hipSuccess) fprintf(stderr, "cooperative launch failed: %s (grid %d)\n", hipGetErrorString(e), grid);
#else
#error multi-launch build removed
#endif
}
```

```cpp
#include <hip/hip_runtime.h>
#include <hip/hip_cooperative_groups.h>
#include <cstdio>
#include <cstdint>
namespace cg = cooperative_groups;

constexpr int D = 1024, SEQ = 2048, NB = 8, DB = 128, DS = 8;
constexpr int MP = NB * SEQ;
constexpr int MS = DB * DS;
constexpr int M = MP + MS;
constexpr int PW = 512, HW = 512, NH = 4, DK = 128, DV = 128, PBUF = 15;
constexpr int FF = 2816, PD = 256, NIN = 4608;
constexpr float EPS = 1e-6f;

namespace pg8 {
#define PG8_LAS __attribute__((address_space(3)))
typedef unsigned short bf16_t;
typedef short bf16x8 __attribute__((ext_vector_type(8)));
typedef float f32x4 __attribute__((ext_vector_type(4)));
typedef float f32x2 __attribute__((ext_vector_type(2)));
typedef unsigned u32x4 __attribute__((ext_vector_type(4)));
typedef unsigned u32x2 __attribute__((ext_vector_type(2)));
constexpr int BM = 256, BK = 64, HALF = 128, HTB = HALF * BK * 2  , STAGE_BYTES = 8 * HTB, NXCD = 8, WGM = 8;

__host__ __device__ __forceinline__ int lds_byte(int r, int c) { const int st = (r >> 4) * 2 + (c >> 5), rr = r & 15, cc = c & 31, ob = rr * 64 + cc * 2; return st * 1024 + (ob ^ (((ob >> 9) & 1) << 5)); }
__host__ __device__ __forceinline__ void stage_rc(int b, int& R, int& C) { const int st = b / 1024, sb = b % 1024, swz = sb ^ (((sb >> 9) & 1) << 5); R = (st >> 1) * 16 + swz / 64; C = (st & 1) * 32 + (swz % 64) / 2; }
__host__ __device__ __forceinline__ int perm32(int rho) { const int n = rho >> 4, i = rho & 15; return 8 * (i >> 2) + 4 * n + (i & 3); }

struct Unit { int pm, pn; };
struct Gemm { const bf16_t* A; const bf16_t* Bt; int M, N, K, lda, ldb; };

struct StaticOrder {
    int nM, nN, nwg, G, c;
    __host__ __device__ void init(int M_, int N_, int G_, int c_) { nM = M_ / BM; nN = N_ / BM; nwg = nM * nN; G = G_; c = c_; }
    __host__ __device__ bool next(int i, Unit& u) const {
        const long L = (long)i * G + c; if (L >= nwg) return false;
        int wgid = (int)L; { const int q = nwg / NXCD, r = nwg % NXCD, xcd = wgid % NXCD, off = wgid / NXCD; wgid = (xcd < r ? xcd * (q + 1) : r * (q + 1) + (xcd - r) * q) + off; }
        const int nig = WGM * nN, gid = wgid / nig, fm = gid * WGM, gsz = (nM - fm) < WGM ? (nM - fm) : WGM;
        u.pm = fm + ((wgid % nig) % gsz); u.pn = (wgid % nig) / gsz; return true;
    }
    __device__ __forceinline__ void a_ready(const Unit&) const {}
    __device__ __forceinline__ void done(const Unit&) const {}
};

typedef __bf16 bf16x2_hw __attribute__((ext_vector_type(2)));
__device__ __forceinline__ unsigned cvt_pk_bf16(float lo, float hi) { const f32x2 v = {lo, hi}; return __builtin_bit_cast(unsigned, __builtin_convertvector(v, bf16x2_hw)); }

template <class Epi, class Sched, bool ALIGN_EPI>
__device__ __forceinline__ void gemm_phase(PG8_LAS unsigned char* lds, const Gemm g, const Sched& S, const Epi& E) {
    const int tid = threadIdx.x, wid = __builtin_amdgcn_readfirstlane(tid >> 6), lane = tid & 63, wr = wid >> 2, wc = wid & 3, fr = lane & 15, fq = lane >> 4;
    int nt = g.K / BK; asm volatile("" : "+s"(nt));
    unsigned voffA[2], voffB[2];
#pragma unroll
    for (int i = 0; i < 2; ++i) { int R, C; stage_rc(tid * 16 + i * 8192, R, C); const int Rb = Epi::PERM ? ((R & ~31) + perm32(R & 31)) : R;
        voffA[i] = (unsigned)(R * g.lda + C) * 2u; voffB[i] = (unsigned)(Rb * g.ldb + C) * 2u; }
    const size_t kstep = (size_t)(BK * 2);
    const size_t hstepA = (size_t)HALF * g.lda * 2, hstepB = (size_t)HALF * g.ldb * 2;
    const size_t tstepA = 2 * hstepA, tstepB = 2 * hstepB;
    const unsigned ldsw = (unsigned)wid * 1024u;
    const int aoff = lds_byte(wr * 64 + fr, fq * 8), boff = lds_byte(wc * 32 + fr, fq * 8);
#define PG8_SA(b, h) (((b) * 2 + (h)) * HTB)
#define PG8_SB(b, h) ((4 + (b) * 2 + (h)) * HTB)
#define PG8_STAGE(bufoff, gbase, voff) do { _Pragma("unroll") for (int _i = 0; _i < 2; ++_i) \
        __builtin_amdgcn_global_load_lds((const unsigned*)((const char*)(gbase) + (voff)[_i]), (PG8_LAS unsigned*)(lds + (bufoff) + ldsw + _i * 8192), 16, 0, 0); } while (0)
#define PG8_LDA(dst, b, h) do { _Pragma("unroll") for (int m = 0; m < 4; ++m) _Pragma("unroll") for (int k = 0; k < 2; ++k) dst[m][k] = *(const PG8_LAS bf16x8*)(lds + PG8_SA(b, h) + aoff + m * 2048 + k * 1024); } while (0)
#define PG8_LDB(dst, b, h) do { _Pragma("unroll") for (int n = 0; n < 2; ++n) _Pragma("unroll") for (int k = 0; k < 2; ++k) dst[n][k] = *(const PG8_LAS bf16x8*)(lds + PG8_SB(b, h) + boff + n * 2048 + k * 1024); } while (0)
#define PG8_MMA(ai, bj, At, Bt) do { __builtin_amdgcn_s_setprio(1); _Pragma("unroll") for (int m = 0; m < 4; ++m) _Pragma("unroll") for (int n = 0; n < 2; ++n) _Pragma("unroll") for (int k = 0; k < 2; ++k) \
        acc[ai][bj][m][n] = __builtin_amdgcn_mfma_f32_16x16x32_bf16(Bt[n][k], At[m][k], acc[ai][bj][m][n], 0, 0, 0); __builtin_amdgcn_s_setprio(0); } while (0)
#define PG8_WAIT_V(n) asm volatile("s_waitcnt vmcnt(" #n ")" ::: "memory")
#define PG8_WAIT_L(n) asm volatile("s_waitcnt lgkmcnt(" #n ")" ::: "memory")
#define PG8_BAR __builtin_amdgcn_s_barrier()
#define PG8_SCHED __builtin_amdgcn_sched_barrier(0)
    Unit cur, nxt; int ui = 0;
    if (!S.next(0, cur)) return;
    f32x4 acc[2][2][4][2];
#pragma unroll
    for (int a = 0; a < 2; ++a)
#pragma unroll
        for (int b = 0; b < 2; ++b)
#pragma unroll
            for (int m = 0; m < 4; ++m)
#pragma unroll
                for (int n = 0; n < 2; ++n) acc[a][b][m][n] = (f32x4){0.f, 0.f, 0.f, 0.f};
    bf16x8 At[4][2], B0[2][2], B1[2][2];
    const char* cA = (const char*)g.A + (size_t)cur.pm * tstepA; const char* cB = (const char*)g.Bt + (size_t)cur.pn * tstepB;
    S.a_ready(cur);
    PG8_STAGE(PG8_SB(0, 0), cB, voffB); PG8_STAGE(PG8_SB(0, 1), cB + hstepB, voffB); PG8_STAGE(PG8_SA(0, 0), cA, voffA); PG8_STAGE(PG8_SA(0, 1), cA + hstepA, voffA);
    if (wr == 1) PG8_BAR;
    PG8_WAIT_V(2); PG8_BAR;
    PG8_STAGE(PG8_SB(1, 0), cB + kstep, voffB); PG8_STAGE(PG8_SA(1, 0), cA + kstep, voffA); PG8_STAGE(PG8_SB(1, 1), cB + hstepB + kstep, voffB);
    PG8_WAIT_V(6); PG8_BAR;
    for (;;) {
        const bool has_next = S.next(ui + 1, nxt);
        const char* nA = has_next ? (const char*)g.A + (size_t)nxt.pm * tstepA : cA; const char* nB = has_next ? (const char*)g.Bt + (size_t)nxt.pn * tstepB : cB;
        for (int t = 0; t < nt; t += 2) {
            const bool last = (t == nt - 2);
            const char* a1 = cA + (size_t)(t + 1) * kstep;
            const char* a2 = last ? nA : cA + (size_t)(t + 2) * kstep; const char* b2 = last ? nB : cB + (size_t)(t + 2) * kstep;
            const char* a3 = a2 + kstep; const char* b3 = b2 + kstep;
            if (last && has_next) S.a_ready(nxt);
            PG8_LDB(B0, 0, 0); PG8_LDB(B1, 0, 1); PG8_SCHED; PG8_LDA(At, 0, 0); PG8_STAGE(PG8_SA(1, 1), a1 + hstepA, voffA);
            PG8_WAIT_V(8); PG8_WAIT_L(0); PG8_BAR; PG8_MMA(0, 0, At, B0); PG8_MMA(0, 1, At, B1); PG8_BAR; PG8_SCHED;
            PG8_LDA(At, 0, 1); PG8_STAGE(PG8_SB(0, 0), b2, voffB); PG8_STAGE(PG8_SB(0, 1), b2 + hstepB, voffB); PG8_STAGE(PG8_SA(0, 0), a2, voffA);
            PG8_WAIT_V(8); PG8_WAIT_L(0); PG8_BAR; PG8_MMA(1, 0, At, B0); PG8_MMA(1, 1, At, B1); PG8_BAR; PG8_SCHED;
            PG8_LDB(B0, 1, 0); PG8_LDB(B1, 1, 1); PG8_SCHED; PG8_LDA(At, 1, 0); PG8_STAGE(PG8_SA(0, 1), a2 + hstepA, voffA);
            PG8_WAIT_V(8); PG8_WAIT_L(0); PG8_BAR; PG8_MMA(0, 0, At, B0); PG8_MMA(0, 1, At, B1); PG8_BAR; PG8_SCHED;
            PG8_LDA(At, 1, 1); PG8_STAGE(PG8_SB(1, 0), b3, voffB); PG8_STAGE(PG8_SB(1, 1), b3 + hstepB, voffB); PG8_STAGE(PG8_SA(1, 0), a3, voffA);
            PG8_WAIT_V(8); PG8_WAIT_L(0); PG8_BAR; PG8_MMA(1, 0, At, B0); PG8_MMA(1, 1, At, B1); PG8_BAR; PG8_SCHED;
        }
        if constexpr (ALIGN_EPI) { if (wr == 0) PG8_BAR; }
        E(acc, cur, wr, wc, fr, fq); S.done(cur);
        if (!has_next) break;
#pragma unroll
        for (int a = 0; a < 2; ++a)
#pragma unroll
            for (int b = 0; b < 2; ++b)
#pragma unroll
                for (int m = 0; m < 4; ++m)
#pragma unroll
                    for (int n = 0; n < 2; ++n) acc[a][b][m][n] = (f32x4){0.f, 0.f, 0.f, 0.f};
        cur = nxt; cA = nA; cB = nB; ++ui;
        if constexpr (ALIGN_EPI) { if (wr == 1) PG8_BAR; }
    }
    PG8_WAIT_V(0);
    if constexpr (!ALIGN_EPI) { if (wr == 0) PG8_BAR; }
    PG8_BAR;
#undef PG8_SA
#undef PG8_SB
#undef PG8_STAGE
#undef PG8_LDA
#undef PG8_LDB
#undef PG8_MMA
#undef PG8_WAIT_V
#undef PG8_WAIT_L
#undef PG8_BAR
#undef PG8_SCHED
}
}

namespace pg8 {
__device__ __forceinline__ float sigm(float x) { return __builtin_amdgcn_rcpf(1.0f + __builtin_amdgcn_exp2f(-1.4426950408889634f * x)); }
__device__ __forceinline__ float silu(float x) { return x * sigm(x); }
__device__ __forceinline__ float bf_lo(unsigned w) { return __uint_as_float(w << 16); }
__device__ __forceinline__ float bf_hi(unsigned w) { return __uint_as_float(w & 0xffff0000u); }
__device__ __forceinline__ u32x4 pack8(const f32x4 a, const f32x4 b) { u32x4 w; w.x = cvt_pk_bf16(a[0], a[1]); w.y = cvt_pk_bf16(a[2], a[3]); w.z = cvt_pk_bf16(b[0], b[1]); w.w = cvt_pk_bf16(b[2], b[3]); return w; }
__device__ __forceinline__ void unpack8(const u32x4 w, f32x4& a, f32x4& b) { a = (f32x4){bf_lo(w.x), bf_hi(w.x), bf_lo(w.y), bf_hi(w.y)}; b = (f32x4){bf_lo(w.z), bf_hi(w.z), bf_lo(w.w), bf_hi(w.w)}; }

template <int N> __device__ __forceinline__ float row_shr(float x) {
    return __int_as_float(__builtin_amdgcn_update_dpp(0, __float_as_int(x), 0x110 + N, 0xf, 0xf, false));
}
__device__ __forceinline__ float row_scan16(float x) { x += row_shr<1>(x); x += row_shr<2>(x); x += row_shr<4>(x); x += row_shr<8>(x); return x; }
__device__ __forceinline__ float row_last(float x) { return __shfl(x, 15, 16); }

struct EpiIn {
    static constexpr bool PERM = true;
    float* U; bf16_t* QE; bf16_t* KE; bf16_t* KDT; float* DEC; float* FG; bf16_t* Vb; bf16_t* VT; bf16_t* SG; bf16_t* GA; bf16_t* GB; const float* rstd; const float* lb;
    __device__ __forceinline__ void operator()(const f32x4 (&acc)[2][2][4][2], const Unit& u, int wr, int wc, int fr, int fq) const {
        const int pn = u.pn, row0 = u.pm * BM + wr * 64 + fr, cl = wc * 32 + 8 * fq;
        if (pn >= 2 && pn < 6) {
            const int h = pn - 2, kc = h * 128 + cl;
            if (u.pm < 64) {
#pragma unroll
                for (int ai = 0; ai < 2; ++ai) {
                    const int chunk = u.pm * 4 + ai * 2 + wr;
                    float rr[4];
#pragma unroll
                    for (int m = 0; m < 4; ++m) rr[m] = rstd[row0 + ai * HALF + m * 16];
#pragma unroll
                    for (int n = 0; n < 2; ++n) {
                        const f32x4 lbv = *(const f32x4*)(lb + kc + 4 * n);
                        f32x4 qe[4], ke[4], dcy;
#pragma unroll
                        for (int e = 0; e < 4; ++e) {
                            float q[4], k1[4], G[4]; float carry = 0.f;
#pragma unroll
                            for (int m = 0; m < 4; ++m) {
                                q[m] = silu(acc[ai][0][m][n][e] * rr[m]);
                                const float fg = lbv[e] + (1.0f - lbv[e]) * sigm(acc[ai][1][m][n][e] * rr[m]);
                                k1[m] = 1.0f - fg;
                                const float x = row_scan16(__logf(fg));
                                G[m] = x + carry; carry += row_last(x);
                            }
                            dcy[e] = __expf(carry);
#pragma unroll
                            for (int m = 0; m < 4; ++m) {
                                qe[m][e] = q[m] * __expf(G[m]);
                                ke[m][e] = k1[m] * __expf(fminf(-G[m], 80.0f));
                                const float kd = k1[m] * __expf(carry - G[m]);
                                KDT[((size_t)chunk * 512 + kc + 4 * n + e) * 64 + m * 16 + fr] = (bf16_t)(cvt_pk_bf16(kd, 0.f) & 0xffffu);
                            }
                        }
#pragma unroll
                        for (int m = 0; m < 4; ++m) {
                            const size_t off = (size_t)(row0 + ai * HALF + m * 16) * 512 + kc + 4 * n;
                            u32x2 wq; wq.x = cvt_pk_bf16(qe[m][0], qe[m][1]); wq.y = cvt_pk_bf16(qe[m][2], qe[m][3]); *(u32x2*)(QE + off) = wq;
                            u32x2 wk; wk.x = cvt_pk_bf16(ke[m][0], ke[m][1]); wk.y = cvt_pk_bf16(ke[m][2], ke[m][3]); *(u32x2*)(KE + off) = wk;
                        }
                        if (fr == 0) *(f32x4*)(DEC + (size_t)chunk * 512 + kc + 4 * n) = dcy;
                    }
                }
            } else {
                f32x4 l0 = *(const f32x4*)(lb + kc), l1 = *(const f32x4*)(lb + kc + 4);
#pragma unroll
                for (int ai = 0; ai < 2; ++ai)
#pragma unroll
                    for (int m = 0; m < 4; ++m) {
                        const int row = row0 + ai * HALF + m * 16; const float r = rstd[row];
                        f32x4 q0 = acc[ai][0][m][0] * r, q1 = acc[ai][0][m][1] * r, f0 = acc[ai][1][m][0] * r, f1 = acc[ai][1][m][1] * r;
#pragma unroll
                        for (int e = 0; e < 4; ++e) { q0[e] = silu(q0[e]); q1[e] = silu(q1[e]); f0[e] = l0[e] + (1.0f - l0[e]) * sigm(f0[e]); f1[e] = l1[e] + (1.0f - l1[e]) * sigm(f1[e]); }
                        const size_t off = (size_t)row * 512 + kc;
                        *(u32x4*)(QE + off) = pack8(q0, q1); *(f32x4*)(FG + off) = f0; *(f32x4*)(FG + off + 4) = f1;
                    }
            }
            return;
        }
        int kind, ld, colt; float* df = nullptr; bf16_t* db = nullptr;
        if (pn < 2)       { kind = 0; df = U;  ld = 512;  colt = 256 * pn; }
        else if (pn < 8)  { kind = 2; db = Vb; ld = 512;  colt = 256 * (pn - 6); }
        else if (pn < 10) { kind = 3; db = SG; ld = 512;  colt = 256 * (pn - 8); }
        else if (pn < 14) { kind = 4; db = GA; ld = 1024; colt = 256 * (pn - 10); }
        else              { kind = 4; db = GB; ld = 1024; colt = 256 * (pn - 14); }
        const int c0 = colt + cl;
        const bool vtr = (kind == 2) && (u.pm < 64);
#pragma unroll
        for (int ai = 0; ai < 2; ++ai)
#pragma unroll
            for (int m = 0; m < 4; ++m) {
                const int row = row0 + ai * HALF + m * 16; const float r = rstd[row];
#pragma unroll
                for (int bj = 0; bj < 2; ++bj) {
                    f32x4 v0 = acc[ai][bj][m][0] * r, v1 = acc[ai][bj][m][1] * r;
                    const size_t off = (size_t)row * ld + c0 + bj * HALF;
                    if (kind == 0) { *(f32x4*)(df + off) = v0; *(f32x4*)(df + off + 4) = v1; }
                    else {
                        if (kind == 3) {
#pragma unroll
                            for (int e = 0; e < 4; ++e) { v0[e] = silu(v0[e]); v1[e] = silu(v1[e]); }
                        } else if (kind == 4) {
#pragma unroll
                            for (int e = 0; e < 4; ++e) { v0[e] = sigm(v0[e]); v1[e] = sigm(v1[e]); }
                        }
                        const u32x4 w = pack8(v0, v1);
                        *(u32x4*)(db + off) = w;
                        if (vtr) {
                            bf16_t* vt = VT + ((size_t)(u.pm * 4 + ai * 2 + wr) * 512 + c0 + bj * HALF) * 64 + m * 16 + fr;
                            vt[0 * 64] = (bf16_t)(w.x & 0xffffu); vt[1 * 64] = (bf16_t)(w.x >> 16); vt[2 * 64] = (bf16_t)(w.y & 0xffffu); vt[3 * 64] = (bf16_t)(w.y >> 16);
                            vt[4 * 64] = (bf16_t)(w.z & 0xffffu); vt[5 * 64] = (bf16_t)(w.z >> 16); vt[6 * 64] = (bf16_t)(w.w & 0xffffu); vt[7 * 64] = (bf16_t)(w.w >> 16);
                        }
                    }
                }
            }
    }
};

struct EpiGateA {
    static constexpr bool PERM = true;
    float* T; const bf16_t* GA;
    __device__ __forceinline__ void operator()(const f32x4 (&acc)[2][2][4][2], const Unit& u, int wr, int wc, int fr, int fq) const {
        const int row0 = u.pm * BM + wr * 64 + fr, c0 = u.pn * BM + wc * 32 + 8 * fq;
#pragma unroll
        for (int ai = 0; ai < 2; ++ai)
#pragma unroll
            for (int m = 0; m < 4; ++m) {
                const int row = row0 + ai * HALF + m * 16;
#pragma unroll
                for (int bj = 0; bj < 2; ++bj) {
                    const size_t off = (size_t)row * 1024 + c0 + bj * HALF;
                    f32x4 g0, g1; unpack8(*(const u32x4*)(GA + off), g0, g1);
                    *(f32x4*)(T + off) = acc[ai][bj][m][0] * g0; *(f32x4*)(T + off + 4) = acc[ai][bj][m][1] * g1;
                }
            }
    }
};
struct EpiGateB {
    static constexpr bool PERM = true;
    const float* T; const bf16_t* GB; bf16_t* MG;
    __device__ __forceinline__ void operator()(const f32x4 (&acc)[2][2][4][2], const Unit& u, int wr, int wc, int fr, int fq) const {
        const int row0 = u.pm * BM + wr * 64 + fr, c0 = u.pn * BM + wc * 32 + 8 * fq;
#pragma unroll
        for (int ai = 0; ai < 2; ++ai)
#pragma unroll
            for (int m = 0; m < 4; ++m) {
                const int row = row0 + ai * HALF + m * 16;
#pragma unroll
                for (int bj = 0; bj < 2; ++bj) {
                    const size_t off = (size_t)row * 1024 + c0 + bj * HALF;
                    f32x4 g0, g1; unpack8(*(const u32x4*)(GB + off), g0, g1);
                    const f32x4 t0 = *(const f32x4*)(T + off), t1 = *(const f32x4*)(T + off + 4);
                    *(u32x4*)(MG + off) = pack8(t0 + acc[ai][bj][m][0] * g0, t1 + acc[ai][bj][m][1] * g1);
                }
            }
    }
};
struct EpiRes {
    static constexpr bool PERM = true;
    const float* base_lo; const float* base_hi; float* out; bf16_t* outb; float* ssq;
    __device__ __forceinline__ void operator()(const f32x4 (&acc)[2][2][4][2], const Unit& u, int wr, int wc, int fr, int fq) const {
        const int row0 = u.pm * BM + wr * 64 + fr, c0 = u.pn * BM + wc * 32 + 8 * fq;
        const float* base = (u.pm < 64) ? base_lo : base_hi;
#pragma unroll
        for (int ai = 0; ai < 2; ++ai)
#pragma unroll
            for (int m = 0; m < 4; ++m) {
                const int row = row0 + ai * HALF + m * 16; float s = 0.f;
#pragma unroll
                for (int bj = 0; bj < 2; ++bj) {
                    const size_t off = (size_t)row * 1024 + c0 + bj * HALF;
                    const f32x4 v0 = *(const f32x4*)(base + off) + acc[ai][bj][m][0], v1 = *(const f32x4*)(base + off + 4) + acc[ai][bj][m][1];
                    *(f32x4*)(out + off) = v0; *(f32x4*)(out + off + 4) = v1;
                    *(u32x4*)(outb + off) = pack8(v0, v1);
                    s += (v0[0] * v0[0] + v0[1] * v0[1]) + (v0[2] * v0[2] + v0[3] * v0[3]) + (v1[0] * v1[0] + v1[1] * v1[1]) + (v1[2] * v1[2] + v1[3] * v1[3]);
                }
                s += __shfl_xor(s, 16); s += __shfl_xor(s, 32);
                if (fq == 0) unsafeAtomicAdd(ssq + row, s);
                if (m & 1) asm volatile("" ::: "memory");
            }
    }
};
struct EpiSwiGLU {
    static constexpr bool PERM = true;
    bf16_t* ACT; const float* ssq;
    __device__ __forceinline__ void operator()(const f32x4 (&acc)[2][2][4][2], const Unit& u, int wr, int wc, int fr, int fq) const {
        const int row0 = u.pm * BM + wr * 64 + fr, c0 = u.pn * HALF + wc * 32 + 8 * fq;
#pragma unroll
        for (int ai = 0; ai < 2; ++ai)
#pragma unroll
            for (int m = 0; m < 4; ++m) {
                const int row = row0 + ai * HALF + m * 16; const float r = __builtin_amdgcn_rsqf(ssq[row] * (1.0f / 1024.0f) + EPS);
                f32x4 a0 = acc[ai][0][m][0] * r, a1 = acc[ai][0][m][1] * r; const f32x4 u0 = acc[ai][1][m][0] * r, u1 = acc[ai][1][m][1] * r;
#pragma unroll
                for (int e = 0; e < 4; ++e) { a0[e] = silu(a0[e]) * u0[e]; a1[e] = silu(a1[e]) * u1[e]; }
                *(u32x4*)(ACT + (size_t)row * FF + c0) = pack8(a0, a1);
            }
    }
};
struct EpiBf {
    static constexpr bool PERM = true;
    bf16_t* O;
    __device__ __forceinline__ void operator()(const f32x4 (&acc)[2][2][4][2], const Unit& u, int wr, int wc, int fr, int fq) const {
        const int row0 = u.pm * BM + wr * 64 + fr, c0 = u.pn * BM + wc * 32 + 8 * fq;
#pragma unroll
        for (int ai = 0; ai < 2; ++ai)
#pragma unroll
            for (int m = 0; m < 4; ++m) {
                const int row = row0 + ai * HALF + m * 16;
#pragma unroll
                for (int bj = 0; bj < 2; ++bj) *(u32x4*)(O + (size_t)row * 1024 + c0 + bj * HALF) = pack8(acc[ai][bj][m][0], acc[ai][bj][m][1]);
            }
    }
};
struct EpiPle {
    static constexpr bool PERM = true;
    float* X; const bf16_t* EMB; const float* ssq_in; float* ssq_out;
    __device__ __forceinline__ void operator()(const f32x4 (&acc)[2][2][4][2], const Unit& u, int wr, int wc, int fr, int fq) const {
        const int row0 = u.pm * BM + wr * 64 + fr, c0 = u.pn * BM + wc * 32 + 8 * fq;
#pragma unroll
        for (int ai = 0; ai < 2; ++ai)
#pragma unroll
            for (int m = 0; m < 4; ++m) {
                const int row = row0 + ai * HALF + m * 16; const float r = __builtin_amdgcn_rsqf(ssq_in[row] * (1.0f / 1024.0f) + EPS); float s = 0.f;
#pragma unroll
                for (int bj = 0; bj < 2; ++bj) {
                    const size_t off = (size_t)row * 1024 + c0 + bj * HALF;
                    f32x4 e0, e1; unpack8(*(const u32x4*)(EMB + off), e0, e1);
                    f32x4 v0 = *(const f32x4*)(X + off), v1 = *(const f32x4*)(X + off + 4);
#pragma unroll
                    for (int e = 0; e < 4; ++e) { v0[e] += sigm(acc[ai][bj][m][0][e] * r) * e0[e]; v1[e] += sigm(acc[ai][bj][m][1][e] * r) * e1[e]; }
                    *(f32x4*)(X + off) = v0; *(f32x4*)(X + off + 4) = v1;
                    s += (v0[0] * v0[0] + v0[1] * v0[1]) + (v0[2] * v0[2] + v0[3] * v0[3]) + (v1[0] * v1[0] + v1[1] * v1[1]) + (v1[2] * v1[2] + v1[3] * v1[3]);
                }
                s += __shfl_xor(s, 16); s += __shfl_xor(s, 32);
                if (fq == 0) unsafeAtomicAdd(ssq_out + row, s);
                if (m & 1) asm volatile("" ::: "memory");
            }
    }
};
}

constexpr int NWAVES = 8;
constexpr size_t MiB = 1u << 20;
constexpr size_t WS_CTL = 0, CTL_ZERO_BYTES = 1 * MiB;
constexpr size_t WS_SMALL = 1 * MiB;
constexpr size_t SM_LB = 0, SM_RSTD0 = 4096, SM_SSQ1 = SM_RSTD0 + 69632 * 1, SM_SSQ2 = SM_SSQ1 + 69632, SM_SSQ3 = SM_SSQ2 + 69632;
constexpr size_t WS_WIN = 2 * MiB;
constexpr size_t WS_WAB = 11 * MiB;
constexpr size_t WS_WOUT = 13 * MiB;
constexpr size_t WS_WGU = 15 * MiB;
constexpr size_t WS_WDN = 26 * MiB;
constexpr size_t WS_WPG = 32 * MiB;
constexpr size_t WS_WPP = 34 * MiB;
constexpr size_t WS_PB = 35 * MiB;
constexpr size_t WS_XB = 44 * MiB;
constexpr size_t WS_QB = 78 * MiB;
constexpr size_t WS_VB = 95 * MiB;
constexpr size_t WS_SG = 112 * MiB;
constexpr size_t WS_GA = 129 * MiB;
constexpr size_t WS_GB = 163 * MiB;
constexpr size_t WS_O = 197 * MiB;
constexpr size_t WS_KE = 197 * MiB, WS_KDT = 214 * MiB;
constexpr size_t WS_ACT = 78 * MiB;
constexpr size_t WS_END = 232 * MiB;
static_assert(WS_ACT + (size_t)M * FF * 2 <= WS_O, "act overlay");
static_assert(WS_WDN + (size_t)D * FF * 2 <= WS_WPG && WS_WPP + (size_t)D * PD * 2 <= WS_PB && WS_PB + (size_t)M * PD * 2 <= WS_XB && WS_XB + (size_t)M * D * 2 <= WS_QB, "ws map");
static_assert(WS_GB + (size_t)M * D * 2 <= WS_O && WS_O + (size_t)M * PW * 4 <= WS_END, "ws map 2");
constexpr size_t OUT_Y = 0, OUT_NPP = (size_t)M * D, OUT_NHP = OUT_NPP + (size_t)NB * PBUF * PW, OUT_NPS = OUT_NHP + (size_t)NB * NH * DK * DV, OUT_NHS = OUT_NPS + (size_t)DB * PBUF * PW,
                 OUT_END = OUT_NHS + (size_t)DB * NH * DK * DV;

constexpr int RING_BYTES = 131072, MISC_OFF = RING_BYTES, LDS_BYTES = 147456;

#define LAS __attribute__((address_space(3)))
typedef unsigned short bf16;
typedef unsigned v4u __attribute__((ext_vector_type(4)));
typedef unsigned v2u __attribute__((ext_vector_type(2)));
typedef float f32x4 __attribute__((ext_vector_type(4)));
#define LDS_WAIT() asm volatile("s_waitcnt lgkmcnt(0)" ::: "memory")
__device__ __forceinline__ unsigned pk2(float lo, float hi) { return pg8::cvt_pk_bf16(lo, hi); }
__device__ __forceinline__ float bf2f(bf16 v) { return __uint_as_float((unsigned)v << 16); }
__device__ __forceinline__ float wave_sum(float v) {
#pragma unroll
    for (int o = 1; o < 64; o <<= 1) v += __shfl_xor(v, o);
    return v;
}

#define XB_TMO      128
#define XB_XCNT(j)  (256  + 64 * (j))
#define XB_XSUB(j)  (1280 + 64 * (j))
#define XB_XGEN(j)  (2304 + 64 * (j))
#define XB_TOP      3328
#define XB_TOPGEN   3392
#define XCD_BAR_WORDS 3456
#define XB_SPIN_CAP (1u << 18)

__device__ __forceinline__ unsigned xb_ld(unsigned* p)              { return __hip_atomic_load(p, __ATOMIC_RELAXED, __HIP_MEMORY_SCOPE_AGENT); }
__device__ __forceinline__ unsigned xb_add(unsigned* p, unsigned v) { return __hip_atomic_fetch_add(p, v, __ATOMIC_RELAXED, __HIP_MEMORY_SCOPE_AGENT); }
__device__ __forceinline__ unsigned xb_xcc_id() { return (unsigned)__builtin_amdgcn_s_getreg((3 << 11) | 20) & 0xFu; }
#define XB_SPIN(cond, bar) do { unsigned _sp = 0; while (cond) { __builtin_amdgcn_s_sleep(1); \
    if ((++_sp & 255u) == 0u) { if (xb_ld(&(bar)[XB_TMO])) break; if (_sp > XB_SPIN_CAP) { atomicAdd(&(bar)[XB_TMO], 1u); break; } } } } while (0)

struct XcdBarrier {
    unsigned* bar; unsigned x;
    volatile LAS unsigned* st;
};

__device__ __forceinline__ XcdBarrier xcd_barrier_post(unsigned* bar, volatile LAS unsigned* st) {
    XcdBarrier b; b.bar = bar; b.x = xb_xcc_id(); b.st = st;
    if (threadIdx.x == 0) (void)xb_add(&bar[XB_XCNT(b.x)], 1u);
    return b;
}
__device__ __forceinline__ void xcd_barrier_complete(unsigned* bar, unsigned x, unsigned& nloc, unsigned& nx) {
    const unsigned G = gridDim.x * gridDim.y * gridDim.z;
    unsigned sum, cnt, mine, sp = 0u;
    for (;;) {
        sum = 0u; cnt = 0u; mine = 0u;
#pragma unroll
        for (unsigned j = 0; j < 16; ++j) { const unsigned c = xb_ld(&bar[XB_XCNT(j)]); sum += c; cnt += (c > 0u) ? 1u : 0u; mine = (j == x) ? c : mine; }
        if (sum == G) break;
        __builtin_amdgcn_s_sleep(1);
        if ((++sp & 255u) == 0u) { if (xb_ld(&bar[XB_TMO])) break; if (sp > XB_SPIN_CAP) { atomicAdd(&bar[XB_TMO], 1u); break; } }
    }
    nloc = mine > 0u ? mine : 1u; nx = cnt > 0u ? cnt : 1u;
}

__device__ __forceinline__ void xcd_barrier(const XcdBarrier& b) {
    asm volatile("s_waitcnt vmcnt(0)" ::: "memory");
    __syncthreads();
    if (threadIdx.x == 0) {
        unsigned* bar = b.bar;
        __builtin_amdgcn_s_waitcnt(0);
        unsigned nloc = b.st[0], nx = b.st[1];
        if (nloc == 0u) { xcd_barrier_complete(bar, b.x, nloc, nx); b.st[0] = nloc; b.st[1] = nx; }
        const unsigned old = xb_add(&bar[XB_XSUB(b.x)], 1u);
        const unsigned gen = old / nloc;
        if (old + 1u == (gen + 1u) * nloc) {
            __builtin_amdgcn_fence(__ATOMIC_RELEASE, "agent");
            asm volatile("s_waitcnt vmcnt(0)" ::: "memory");
            const unsigned og = xb_add(&bar[XB_TOP], 1u);
            const unsigned tg = og / nx;
            if (og + 1u == (tg + 1u) * nx) xb_add(&bar[XB_TOPGEN], 1u);
            else XB_SPIN(xb_ld(&bar[XB_TOPGEN]) == tg, bar);
            __builtin_amdgcn_fence(__ATOMIC_ACQUIRE, "agent");
            xb_add(&bar[XB_XGEN(b.x)], 1u);
            asm volatile("s_waitcnt vmcnt(0)" ::: "memory");
        } else {
            XB_SPIN(xb_ld(&bar[XB_XGEN(b.x)]) == gen, bar);
            __builtin_amdgcn_fence(__ATOMIC_ACQUIRE, "agent");
            asm volatile("s_waitcnt vmcnt(0)" ::: "memory");
        }
    }
    __syncthreads();
}

struct Frame {
    LAS unsigned char* lds;
    int tid, lane, wave, G, wg;
    float* out; unsigned char* ws;
};
struct Args { const float* in[23]; float* out; unsigned char* ws; unsigned long long prog; };
static_assert(sizeof(Args) == 23 * 8 + 8 + 8 + 8, "Args has no padding");
enum { I_XP = 0, I_XS, I_SPOOL, I_SHGRN, I_PP, I_PS, I_GMIX, I_WIN, I_WPMIX, I_PSCALE, I_HLB, I_HNORM, I_WPUP, I_WHUP, I_WOUT, I_GFFN, I_WFG, I_WFU, I_WFD, I_GPLE, I_WPG, I_WPPJ, I_GFIN };

__device__ __forceinline__ void p0_transpose_item(const float* W, int N, const float* gain, bf16* WT, int ldk, int drow, int k0, int n0, int koff, LAS float* scr, int lane) {
#pragma unroll 8
    for (int i = 0; i < 32; ++i) { const int kk = 2 * i + (lane >> 5); float v = W[(size_t)(k0 + kk) * N + n0 + (lane & 31)]; if (gain) v *= gain[k0 + kk]; scr[kk * 33 + (lane & 31)] = v; }
    LDS_WAIT(); asm volatile("" ::: "memory");
    const int c = lane & 7;
#pragma unroll
    for (int j = 0; j < 4; ++j) { const int n = (lane >> 3) + 8 * j; const LAS float* s = scr + (8 * c) * 33 + n;
        v4u o; o.x = pk2(s[0 * 33], s[1 * 33]); o.y = pk2(s[2 * 33], s[3 * 33]); o.z = pk2(s[4 * 33], s[5 * 33]); o.w = pk2(s[6 * 33], s[7 * 33]);
        *(v4u*)(WT + (size_t)(drow + n) * ldk + koff + k0 + 8 * c) = o; }
    LDS_WAIT(); asm volatile("" ::: "memory");
}
__device__ __forceinline__ void p0_fold_item(const float* w_pool_mix, const float* w_pool_up, const float* pool_scale, bf16* WAB, int item, int lane) {
    const int g = item >> 7, cb = (item >> 4) & 7, nb = item & 15, n = nb * 64 + lane, c0 = cb * 16;
    float a[16];
#pragma unroll
    for (int c = 0; c < 16; ++c) a[c] = 0.f;
    const float* mix = w_pool_mix + (size_t)g * 128 * 128 + (size_t)c0 * 128;
    for (int d = 0; d < 128; ++d) {
        const float w = w_pool_up[(size_t)(g * 128 + d) * D + n] * pool_scale[g * 128 + d];
#pragma unroll
        for (int c = 0; c < 16; ++c) a[c] += mix[c * 128 + d] * w;
    }
    v4u o0, o1; o0.x = pk2(a[0], a[1]); o0.y = pk2(a[2], a[3]); o0.z = pk2(a[4], a[5]); o0.w = pk2(a[6], a[7]); o1.x = pk2(a[8], a[9]); o1.y = pk2(a[10], a[11]); o1.z = pk2(a[12], a[13]); o1.w = pk2(a[14], a[15]);
    bf16* dst = WAB + (size_t)n * 1024 + g * 128 + c0; *(v4u*)dst = o0; *(v4u*)(dst + 8) = o1;
}
__device__ __forceinline__ void p0_prologue(const Frame& F, const Args& A) {
    LAS float* scr = (LAS float*)(F.lds + F.wave * 16384);
    const int gw = F.wg * NWAVES + F.wave, NGW = F.G * NWAVES, lane = F.lane;
    unsigned char* ws = F.ws;
    bf16 *WIN = (bf16*)(ws + WS_WIN), *WAB = (bf16*)(ws + WS_WAB), *WOUT = (bf16*)(ws + WS_WOUT), *WGU = (bf16*)(ws + WS_WGU), *WDN = (bf16*)(ws + WS_WDN), *WPG = (bf16*)(ws + WS_WPG), *WPP = (bf16*)(ws + WS_WPP);
    constexpr int NI_IN = 16 * 144, NI_HU = 8 * 32, NI_OUT = 16 * 32, NI_G = 16 * 88, NI_DN = 44 * 32, NI_PG = 16 * 32, NI_PP = 4 * 32, NI_FOLD = 512;
    constexpr int NITEMS = NI_IN + NI_HU + NI_OUT + 2 * NI_G + NI_DN + NI_PG + NI_PP + NI_FOLD;
    for (int it = gw; it < NITEMS; it += NGW) {
        int r = it;
        if (r < NI_IN) { const int kb = r / 144, nb = r % 144, n0 = 32 * nb;
            const int drow = (n0 >= 512 && n0 < 1024) ? 512 + ((n0 - 512) >> 7) * 256 + ((n0 - 512) & 127) : (n0 >= 1024 && n0 < 1536) ? 512 + ((n0 - 1024) >> 7) * 256 + 128 + ((n0 - 1024) & 127) : n0;
            p0_transpose_item(A.in[I_WIN], NIN, A.in[I_GMIX], WIN, 1024, drow, 64 * kb, n0, 0, scr, lane); continue; } r -= NI_IN;
        if (r < NI_HU) { const int kb = r / 32, nb = r % 32; p0_transpose_item(A.in[I_WHUP], D, nullptr, WAB, 1024, 32 * nb, 64 * kb, 32 * nb, 512, scr, lane); continue; } r -= NI_HU;
        if (r < NI_OUT) { const int kb = r / 32, nb = r % 32; p0_transpose_item(A.in[I_WOUT], D, nullptr, WOUT, 1024, 32 * nb, 64 * kb, 32 * nb, 0, scr, lane); continue; } r -= NI_OUT;
        if (r < NI_G) { const int kb = r / 88, nb = r % 88, n0 = 32 * nb; p0_transpose_item(A.in[I_WFG], FF, A.in[I_GFFN], WGU, 1024, (n0 >> 7) * 256 + (n0 & 127), 64 * kb, n0, 0, scr, lane); continue; } r -= NI_G;
        if (r < NI_G) { const int kb = r / 88, nb = r % 88, n0 = 32 * nb; p0_transpose_item(A.in[I_WFU], FF, A.in[I_GFFN], WGU, 1024, (n0 >> 7) * 256 + 128 + (n0 & 127), 64 * kb, n0, 0, scr, lane); continue; } r -= NI_G;
        if (r < NI_DN) { const int kb = r / 32, nb = r % 32; p0_transpose_item(A.in[I_WFD], D, nullptr, WDN, FF, 32 * nb, 64 * kb, 32 * nb, 0, scr, lane); continue; } r -= NI_DN;
        if (r < NI_PG) { const int kb = r / 32, nb = r % 32; p0_transpose_item(A.in[I_WPG], D, A.in[I_GPLE], WPG, 1024, 32 * nb, 64 * kb, 32 * nb, 0, scr, lane); continue; } r -= NI_PG;
        if (r < NI_PP) { const int kb = r / 32, nb = r % 32; p0_transpose_item(A.in[I_WPPJ], D, nullptr, WPP, 256, 32 * nb, 64 * kb, 32 * nb, 0, scr, lane); continue; } r -= NI_PP;
        p0_fold_item(A.in[I_WPMIX], A.in[I_WPUP], A.in[I_PSCALE], WAB, r, lane);
    }
    bf16* XB = (bf16*)(ws + WS_XB); bf16* PB = (bf16*)(ws + WS_PB);
    float* small = (float*)(ws + WS_SMALL);
    float* RSTD0 = (float*)((char*)small + SM_RSTD0); float* SSQ1 = (float*)((char*)small + SM_SSQ1);
    for (int m = gw; m < M; m += NGW) {
        const float* xrow = (m < MP) ? A.in[I_XP] + (size_t)m * D : A.in[I_XS] + (size_t)(m - MP) * D;
        const f32x4* xr = (const f32x4*)xrow + lane; f32x4 v[4]; float s = 0.f;
#pragma unroll
        for (int j = 0; j < 4; ++j) { v[j] = xr[64 * j]; s += (v[j].x * v[j].x + v[j].y * v[j].y) + (v[j].z * v[j].z + v[j].w * v[j].w); }
        s = wave_sum(s);
        v2u* o8 = (v2u*)(XB + (size_t)m * D) + lane;
#pragma unroll
        for (int j = 0; j < 4; ++j) { v2u w; w.x = pk2(v[j].x, v[j].y); w.y = pk2(v[j].z, v[j].w); o8[64 * j] = w; }
        const float* prow = (m < MP) ? A.in[I_PP] + (size_t)m * PD : A.in[I_PS] + (size_t)(m - MP) * PD;
        const f32x4 pv = ((const f32x4*)prow)[lane]; v2u pw; pw.x = pk2(pv.x, pv.y); pw.y = pk2(pv.z, pv.w); ((v2u*)(PB + (size_t)m * PD))[lane] = pw;
        if (lane == 0) { RSTD0[m] = 1.0f / sqrtf(s * (1.0f / D) + EPS); }
        if (lane < 3) SSQ1[lane * M + m] = 0.f;
    }
    if (F.wg == 0) { float* LB = (float*)((char*)small + SM_LB); const int c = F.tid; if (c < 512) { const float a0 = A.in[I_HLB][c], a1 = A.in[I_HLB][512 + c]; LB[c] = 1.0f / (1.0f + expf(a1 - a0)); } }
}

__device__ __forceinline__ void p2_pool(const Frame& F, const Args& A, int wg0) {
    const float* U = F.out + OUT_Y; bf16* AB = (bf16*)(F.ws + WS_XB);
    const int gt = (F.wg - wg0) * (NWAVES * 64) + F.tid, NT = (F.G - wg0) * NWAVES * 64;
    for (int idx = gt; idx < M * PW; idx += NT) {
        const int m = idx >> 9, c = idx & 511, g = c >> 7, w = 2 << g; float s = 0.f; int cnt;
        if (m < MP) { const int t = m & (SEQ - 1); cnt = (t + 1 < w) ? t + 1 : w; for (int j = 0; j < cnt; ++j) s += U[(size_t)(m - j) * PW + c]; }
        else { const int ms = m - MP, b = ms >> 3, t = ms & 7; cnt = w;
            for (int j = 0; j < w; ++j) s += (t - j >= 0) ? U[(size_t)(m - j) * PW + c] : A.in[I_SPOOL][((size_t)b * PBUF + (PBUF + t - j)) * PW + c]; }
        const float pooled = s / (float)cnt - U[(size_t)m * PW + c];
        AB[(size_t)m * 1024 + c] = (bf16)(pk2(pooled, 0.f) & 0xffffu);
    }
    float* NPP = F.out + OUT_NPP; float* NPS = F.out + OUT_NPS;
    for (int idx = gt; idx < NB * PBUF * PW; idx += NT) { const int c = idx & 511, i = (idx >> 9) % PBUF, b = (idx >> 9) / PBUF; NPP[idx] = U[((size_t)b * SEQ + SEQ - PBUF + i) * PW + c]; }
    for (int idx = gt; idx < DB * PBUF * PW; idx += NT) { const int c = idx & 511, i = (idx >> 9) % PBUF, b = (idx >> 9) / PBUF;
        NPS[idx] = (i < 7) ? A.in[I_SPOOL][((size_t)b * PBUF + 8 + i) * PW + c] : U[((size_t)MP + b * DS + (i - 7)) * PW + c]; }
}

__device__ __forceinline__ void p2_rec_sample(const Frame& F, const Args& A, int item) {
    const float* FG = F.out + OUT_Y + (size_t)M * PW; const bf16* QB = (const bf16*)(F.ws + WS_QB); const bf16* VB = (const bf16*)(F.ws + WS_VB); const bf16* SG = (const bf16*)(F.ws + WS_SG); bf16* AB = (bf16*)(F.ws + WS_XB);
    LAS float* Fs = (LAS float*)(F.lds); LAS float* Qs = Fs + DS * 128; LAS float* Vs = Qs + DS * 128; LAS float* Os = Vs + DS * 128;
    const int tid = F.tid, vi = tid >> 2, kg = tid & 3;
    const int b = item >> 2, h = item & 3, row0 = MP + b * DS;
    const float* s0 = A.in[I_SHGRN] + (size_t)item * DK * DV; float* sout = F.out + OUT_NHS + (size_t)item * DK * DV;
    float S[32];
#pragma unroll
    for (int i = 0; i < 32; ++i) S[i] = s0[(size_t)(kg * 32 + i) * DV + vi];
    for (int idx = tid; idx < DS * 128; idx += 512) { const int tt = idx >> 7, c = idx & 127; const size_t g = (size_t)(row0 + tt) * HW + h * 128 + c; Fs[idx] = FG[g]; Qs[idx] = bf2f(QB[g]); Vs[idx] = bf2f(VB[g]); }
    __syncthreads();
#pragma unroll 1
    for (int tt = 0; tt < DS; ++tt) {
        const float v = Vs[tt * 128 + vi]; float a = 0.f;
        const LAS f32x4* fp = (const LAS f32x4*)(Fs + tt * 128 + kg * 32); const LAS f32x4* qp = (const LAS f32x4*)(Qs + tt * 128 + kg * 32);
#pragma unroll
        for (int i4 = 0; i4 < 8; ++i4) { const f32x4 f = fp[i4], q = qp[i4];
#pragma unroll
            for (int e = 0; e < 4; ++e) { const int i = i4 * 4 + e; S[i] = f[e] * S[i] + (1.0f - f[e]) * v; a += S[i] * q[e]; } }
        a += __shfl_xor(a, 1); a += __shfl_xor(a, 2);
        if (kg == 0) Os[tt * 128 + vi] = a;
    }
#pragma unroll
    for (int i = 0; i < 32; ++i) sout[(size_t)(kg * 32 + i) * DV + vi] = S[i];
    __syncthreads();
    {
        const int t = tid >> 6, c = 2 * (tid & 63); const float o0 = Os[t * 128 + c], o1 = Os[t * 128 + c + 1];
        const float ss = wave_sum(o0 * o0 + o1 * o1); const float r = 1.0f / sqrtf(ss * (1.0f / DV) + EPS);
        const size_t g = (size_t)(row0 + t) * HW + h * 128 + c; const unsigned sgw = *(const unsigned*)(SG + g);
        const float n0 = A.in[I_HNORM][h * 128 + c], n1 = A.in[I_HNORM][h * 128 + c + 1];
        *(unsigned*)(AB + (size_t)(row0 + t) * 1024 + 512 + h * 128 + c) = pk2(o0 * r * n0 * pg8::bf_lo(sgw), o1 * r * n1 * pg8::bf_hi(sgw));
    }
    __syncthreads();
}

constexpr int RQ_RS = 288, RK_RS = 160;
constexpr int L_QE = 0, L_KE = L_QE + 64 * RQ_RS, L_KDT = L_KE + 64 * RQ_RS, L_VT = L_KDT + 128 * RK_RS, L_DEC = L_VT + 128 * RK_RS, L_O = L_DEC + 512, O_RS = 132 * 4, L_END = L_O + 64 * O_RS;
static_assert(L_END <= RING_BYTES, "recurrence LDS map");
typedef short bf16x8v __attribute__((ext_vector_type(8)));
__device__ __forceinline__ void p2_rec_prompt(const Frame& F, const Args& A, int seq) {
    using pg8::cvt_pk_bf16;
    const bf16* QE = (const bf16*)(F.ws + WS_QB); const bf16* KE = (const bf16*)(F.ws + WS_KE); const bf16* SG = (const bf16*)(F.ws + WS_SG); bf16* AB = (bf16*)(F.ws + WS_XB);
    const bf16* KDT = (const bf16*)(F.ws + WS_KDT); const bf16* VT = (const bf16*)(F.out + OUT_Y + (size_t)M * PW); const float* DEC = (const float*)((const char*)(F.out + OUT_Y + (size_t)M * PW) + 16 * MiB);
    LAS unsigned char* lds = F.lds;
    const int tid = F.tid, lane = F.lane, w = F.wave, idx = lane & 15, g = lane >> 4;
    const int b = seq >> 2, h = seq & 3, row0 = b * SEQ, chunk0 = b * (SEQ / 64);
    unsigned gq[2], lq[2], gk[2], lk[2];
#pragma unroll
    for (int j = 0; j < 2; ++j) {
        const int q = tid + 512 * j;
        { const int row = q >> 4, c16 = q & 15, kb = c16 >> 2, c = c16 & 3; gq[j] = (unsigned)(row * 512 + c16 * 8) * 2u; lq[j] = (unsigned)(row * RQ_RS + kb * 64 + (16 * (c & 1) + 4 * (c >> 1)) * 2); }
        { const int row = q >> 3, c8 = q & 7, sb = c8 >> 2, c = c8 & 3; gk[j] = (unsigned)(row * 64 + c8 * 8) * 2u; lk[j] = (unsigned)(row * RK_RS + sb * 64 + (16 * (c & 1) + 4 * (c >> 1)) * 2); }
    }
    v4u pf[8]; f32x4 pfd;
#define REC_LOAD(n_) do { const size_t rb = (size_t)(row0 + 64 * (n_)) * 512 + h * 128; const size_t cb = ((size_t)(chunk0 + (n_)) * 512 + h * 128) * 64; \
        _Pragma("unroll") for (int j = 0; j < 2; ++j) { pf[j] = *(const v4u*)((const char*)(QE + rb) + gq[j]); pf[2 + j] = *(const v4u*)((const char*)(KE + rb) + gq[j]); \
            pf[4 + j] = *(const v4u*)((const char*)(KDT + cb) + gk[j]); pf[6 + j] = *(const v4u*)((const char*)(VT + cb) + gk[j]); } \
        if (tid < 32) pfd = *(const f32x4*)(DEC + (size_t)(chunk0 + (n_)) * 512 + h * 128 + tid * 4); } while (0)
#define REC_STORE() do { _Pragma("unroll") for (int j = 0; j < 2; ++j) { \
            *(LAS v2u*)(lds + L_QE + lq[j]) = (v2u){pf[j].x, pf[j].y}; *(LAS v2u*)(lds + L_QE + lq[j] + 16) = (v2u){pf[j].z, pf[j].w}; \
            *(LAS v2u*)(lds + L_KE + lq[j]) = (v2u){pf[2 + j].x, pf[2 + j].y}; *(LAS v2u*)(lds + L_KE + lq[j] + 16) = (v2u){pf[2 + j].z, pf[2 + j].w}; \
            *(LAS v2u*)(lds + L_KDT + lk[j]) = (v2u){pf[4 + j].x, pf[4 + j].y}; *(LAS v2u*)(lds + L_KDT + lk[j] + 16) = (v2u){pf[4 + j].z, pf[4 + j].w}; \
            *(LAS v2u*)(lds + L_VT + lk[j]) = (v2u){pf[6 + j].x, pf[6 + j].y}; *(LAS v2u*)(lds + L_VT + lk[j] + 16) = (v2u){pf[6 + j].z, pf[6 + j].w}; } \
        if (tid < 32) *(LAS f32x4*)(lds + L_DEC + tid * 16) = pfd; } while (0)
    f32x4 S[8];
#pragma unroll
    for (int kt = 0; kt < 8; ++kt) S[kt] = (f32x4){0.f, 0.f, 0.f, 0.f};
    const unsigned fq_ = (unsigned)(L_QE + idx * RQ_RS + g * 16), fk_ = (unsigned)(L_KE + idx * RQ_RS + g * 16), fd_ = (unsigned)(L_KDT + idx * RK_RS + g * 16), fv_ = (unsigned)(L_VT + (16 * w + idx) * RK_RS + g * 16);
    const int et = tid >> 3, evq = tid & 7;
    f32x4 hn[4];
#pragma unroll
    for (int i = 0; i < 4; ++i) hn[i] = *(const f32x4*)(A.in[I_HNORM] + h * 128 + 16 * evq + 4 * i);
    REC_LOAD(0); REC_STORE(); __syncthreads();
#pragma unroll 1
    for (int n = 0; n < SEQ / 64; ++n) {
        if (n + 1 < SEQ / 64) REC_LOAD(n + 1);
        const size_t erow = (size_t)(row0 + 64 * n + et);
        const v4u sg0 = *(const v4u*)(SG + erow * HW + h * 128 + 16 * evq), sg1 = *(const v4u*)(SG + erow * HW + h * 128 + 16 * evq + 8);
        f32x4 at[4][4], o[4]; bf16x8v vt[2];
#pragma unroll
        for (int tt = 0; tt < 4; ++tt) { o[tt] = (f32x4){0.f, 0.f, 0.f, 0.f};
#pragma unroll
            for (int st = 0; st < 4; ++st) at[tt][st] = (f32x4){0.f, 0.f, 0.f, 0.f}; }
#pragma unroll
        for (int sb = 0; sb < 2; ++sb) vt[sb] = *(const LAS bf16x8v*)(lds + fv_ + sb * 64);
#pragma unroll
        for (int kb = 0; kb < 4; ++kb) {
            bf16x8v qf[4], kf[4];
#pragma unroll
            for (int t4 = 0; t4 < 4; ++t4) { qf[t4] = *(const LAS bf16x8v*)(lds + fq_ + t4 * 16 * RQ_RS + kb * 64); kf[t4] = *(const LAS bf16x8v*)(lds + fk_ + t4 * 16 * RQ_RS + kb * 64); }
            union { bf16x8v v; unsigned u[4]; } sb_;
            sb_.u[0] = cvt_pk_bf16(S[2 * kb][0], S[2 * kb][1]); sb_.u[1] = cvt_pk_bf16(S[2 * kb][2], S[2 * kb][3]); sb_.u[2] = cvt_pk_bf16(S[2 * kb + 1][0], S[2 * kb + 1][1]); sb_.u[3] = cvt_pk_bf16(S[2 * kb + 1][2], S[2 * kb + 1][3]);
#pragma unroll
            for (int tt = 0; tt < 4; ++tt) {
                o[tt] = __builtin_amdgcn_mfma_f32_16x16x32_bf16(qf[tt], sb_.v, o[tt], 0, 0, 0);
#pragma unroll
                for (int st = 0; st < 4; ++st) if (st <= tt) at[tt][st] = __builtin_amdgcn_mfma_f32_16x16x32_bf16(kf[st], qf[tt], at[tt][st], 0, 0, 0);
            }
        }
#pragma unroll
        for (int tt = 0; tt < 4; ++tt) {
#pragma unroll
            for (int r = 0; r < 4; ++r) if (4 * g + r > idx) at[tt][tt][r] = 0.f;
#pragma unroll
            for (int sb = 0; sb < 2; ++sb) if (2 * sb <= tt) {
                union { bf16x8v v; unsigned u[4]; } ab;
                ab.u[0] = cvt_pk_bf16(at[tt][2 * sb][0], at[tt][2 * sb][1]); ab.u[1] = cvt_pk_bf16(at[tt][2 * sb][2], at[tt][2 * sb][3]);
                if (2 * sb + 1 <= tt) { ab.u[2] = cvt_pk_bf16(at[tt][2 * sb + 1][0], at[tt][2 * sb + 1][1]); ab.u[3] = cvt_pk_bf16(at[tt][2 * sb + 1][2], at[tt][2 * sb + 1][3]); } else { ab.u[2] = 0u; ab.u[3] = 0u; }
                o[tt] = __builtin_amdgcn_mfma_f32_16x16x32_bf16(ab.v, vt[sb], o[tt], 0, 0, 0);
            }
        }
#pragma unroll
        for (int kt = 0; kt < 8; ++kt) {
            const f32x4 dc = *(const LAS f32x4*)(lds + L_DEC + (16 * kt + 4 * g) * 4);
            f32x4 s_ = S[kt] * dc;
#pragma unroll
            for (int sb = 0; sb < 2; ++sb) s_ = __builtin_amdgcn_mfma_f32_16x16x32_bf16(*(const LAS bf16x8v*)(lds + fd_ + kt * 16 * RK_RS + sb * 64), vt[sb], s_, 0, 0, 0);
            S[kt] = s_;
        }
#pragma unroll
        for (int tt = 0; tt < 4; ++tt)
#pragma unroll
            for (int r = 0; r < 4; ++r) *(LAS float*)(lds + L_O + (16 * tt + 4 * g + r) * O_RS + (16 * w + idx) * 4) = o[tt][r];
        __syncthreads();
        {
            f32x4 ov[4]; float ss = 0.f;
#pragma unroll
            for (int i = 0; i < 4; ++i) { ov[i] = *(const LAS f32x4*)(lds + L_O + et * O_RS + (16 * evq + 4 * i) * 4); ss += (ov[i][0] * ov[i][0] + ov[i][1] * ov[i][1]) + (ov[i][2] * ov[i][2] + ov[i][3] * ov[i][3]); }
            ss += __shfl_xor(ss, 1); ss += __shfl_xor(ss, 2); ss += __shfl_xor(ss, 4);
            const float r = 1.0f / sqrtf(ss * (1.0f / DV) + EPS);
            f32x4 g0, g1, g2, g3; pg8::unpack8(sg0, g0, g1); pg8::unpack8(sg1, g2, g3);
            bf16* dst = AB + erow * 1024 + 512 + h * 128 + 16 * evq;
            *(v4u*)dst = pg8::pack8(ov[0] * r * hn[0] * g0, ov[1] * r * hn[1] * g1); *(v4u*)(dst + 8) = pg8::pack8(ov[2] * r * hn[2] * g2, ov[3] * r * hn[3] * g3);
        }
        if (n + 1 < SEQ / 64) REC_STORE();
        __syncthreads();
    }
    float* sout = F.out + OUT_NHP + (size_t)seq * DK * DV;
#pragma unroll
    for (int kt = 0; kt < 8; ++kt)
#pragma unroll
        for (int r = 0; r < 4; ++r) sout[(size_t)(16 * kt + 4 * g + r) * DV + 16 * w + idx] = S[kt][r];
#undef REC_LOAD
#undef REC_STORE
}
__device__ __forceinline__ void p_final(const Frame& F, const Args& A) {
    float* Y = F.out + OUT_Y; const float* SSQ3 = (const float*)(F.ws + WS_SMALL + SM_SSQ3);
    const int gw = F.wg * NWAVES + F.wave, NGW = F.G * NWAVES, lane = F.lane;
    f32x4 gf[4];
#pragma unroll
    for (int j = 0; j < 4; ++j) gf[j] = ((const f32x4*)A.in[I_GFIN])[lane + 64 * j];
    for (int m = gw; m < M; m += NGW) {
        const float r = 1.0f / sqrtf(SSQ3[m] * (1.0f / D) + EPS);
        f32x4* yr = (f32x4*)(Y + (size_t)m * D) + lane;
#pragma unroll
        for (int j = 0; j < 4; ++j) yr[64 * j] = yr[64 * j] * r * gf[j];
    }
}

#ifndef MK_N_LAUNCHES
#define MK_N_LAUNCHES 1
#endif
constexpr int N_PHASES = 12;
#ifndef PROG
#define PROG 0xff7ull
#endif

__global__ void __launch_bounds__(NWAVES * 64, 2) fwd_kernel(Args args) {
    extern __shared__ __attribute__((aligned(16))) unsigned char lds_raw[];
    Frame F;
    F.lds = (LAS unsigned char*)lds_raw;
    F.tid = threadIdx.x; F.lane = F.tid & 63; F.wave = __builtin_amdgcn_readfirstlane(F.tid >> 6);
    F.G = gridDim.x; F.wg = blockIdx.x;
    F.out = args.out; F.ws = args.ws;
    unsigned char* ws = args.ws;
    using namespace pg8;
    float* small = (float*)(ws + WS_SMALL);
    float* LB = (float*)((char*)small + SM_LB); float* RSTD0 = (float*)((char*)small + SM_RSTD0);
    float* SSQ1 = (float*)((char*)small + SM_SSQ1); float* SSQ2 = (float*)((char*)small + SM_SSQ2); float* SSQ3 = (float*)((char*)small + SM_SSQ3);
    bf16_t *WIN = (bf16_t*)(ws + WS_WIN), *WAB = (bf16_t*)(ws + WS_WAB), *WOUT = (bf16_t*)(ws + WS_WOUT), *WGU = (bf16_t*)(ws + WS_WGU), *WDN = (bf16_t*)(ws + WS_WDN), *WPG = (bf16_t*)(ws + WS_WPG), *WPP = (bf16_t*)(ws + WS_WPP);
    bf16_t *PB = (bf16_t*)(ws + WS_PB), *XB = (bf16_t*)(ws + WS_XB), *QB = (bf16_t*)(ws + WS_QB), *VB = (bf16_t*)(ws + WS_VB), *SG = (bf16_t*)(ws + WS_SG), *GA = (bf16_t*)(ws + WS_GA), *GB = (bf16_t*)(ws + WS_GB);
    bf16_t *MG = (bf16_t*)(ws + WS_O), *EMB = (bf16_t*)(ws + WS_O), *ACT = (bf16_t*)(ws + WS_ACT);
    float* Y = F.out + OUT_Y; float* U = Y; float* FGp = Y + (size_t)M * PW; float* T = Y;
    const int c = (int)blockIdx.x;

#define IN(k) ((pmask >> (k)) & 1u)
#define SEAM(k) do { if (IN(k) && (pmask >> ((k) + 1))) { xcd_barrier(bar); } } while (0)
#ifndef PROBE_DUP
#define PROBE_DUP 0x0
#endif
#define DUP(k) ((PROBE_DUP >> (k)) & 1)
    const unsigned pmask = (unsigned)args.prog;
    for (int u = F.tid; u < (LDS_BYTES - MISC_OFF) / 4; u += NWAVES * 64) ((LAS unsigned*)(F.lds + MISC_OFF))[u] = 0u;
    __syncthreads();
    XcdBarrier bar = xcd_barrier_post((unsigned*)(ws + WS_CTL), (volatile LAS unsigned*)(F.lds + MISC_OFF) + 8);
    if (pmask & 0x80000000u) cg::this_grid().sync();
#define PH0 { p0_prologue(F, args); }
#define PH1 { Gemm g{XB, WIN, M, NIN, D, D, D}; StaticOrder S; S.init(M, NIN, F.G, c); EpiIn E{U, QB, (bf16_t*)(ws + WS_KE), (bf16_t*)(ws + WS_KDT), (float*)((char*)FGp + 16 * MiB), FGp, VB, (bf16_t*)FGp, SG, GA, GB, RSTD0, LB}; gemm_phase<EpiIn, StaticOrder, true>(F.lds, g, S, E); }
#define PH2 { if (F.wg < 32) p2_rec_prompt(F, args, F.wg); else { p2_pool(F, args, 32); for (int it = F.wg - 32; it < 512; it += F.G - 32) p2_rec_sample(F, args, it); } }
#define PH3 { }
#define PH4 { Gemm g{XB, WAB, M, D, 512, D, D}; StaticOrder S; S.init(M, D, F.G, c); EpiGateA E{T, GA}; gemm_phase<EpiGateA, StaticOrder, true>(F.lds, g, S, E); }
#define PH5 { Gemm g{XB + 512, WAB + 512, M, D, 512, D, D}; StaticOrder S; S.init(M, D, F.G, c); EpiGateB E{T, GB, MG}; gemm_phase<EpiGateB, StaticOrder, true>(F.lds, g, S, E); }
#define PH6 { Gemm g{MG, WOUT, M, D, D, D, D}; StaticOrder S; S.init(M, D, F.G, c); EpiRes E{args.in[I_XP], args.in[I_XS] - (size_t)MP * D, Y, XB, SSQ1}; gemm_phase<EpiRes, StaticOrder, true>(F.lds, g, S, E); }
#define PH7 { Gemm g{XB, WGU, M, 2 * FF, D, D, D}; StaticOrder S; S.init(M, 2 * FF, F.G, c); EpiSwiGLU E{ACT, SSQ1}; gemm_phase<EpiSwiGLU, StaticOrder, true>(F.lds, g, S, E); }
#define PH8 { Gemm g{ACT, WDN, M, D, FF, FF, FF}; StaticOrder S; S.init(M, D, F.G, c); EpiRes E{Y, Y, Y, XB, SSQ2}; gemm_phase<EpiRes, StaticOrder, true>(F.lds, g, S, E); }
#define PH9 { Gemm g{PB, WPP, M, D, PD, PD, PD}; StaticOrder S; S.init(M, D, F.G, c); EpiBf E{EMB}; gemm_phase<EpiBf, StaticOrder, true>(F.lds, g, S, E); }
#define PH10 { Gemm g{XB, WPG, M, D, D, D, D}; StaticOrder S; S.init(M, D, F.G, c); EpiPle E{Y, EMB, SSQ2, SSQ3}; gemm_phase<EpiPle, StaticOrder, true>(F.lds, g, S, E); }
#define PH11 { p_final(F, args); }
#define RUN(k, BODY) if (IN(k)) { BODY if (DUP(k)) { xcd_barrier(bar); BODY } } SEAM(k);
    RUN(0, PH0) RUN(1, PH1) RUN(2, PH2) RUN(3, PH3) RUN(4, PH4) RUN(5, PH5) RUN(6, PH6) RUN(7, PH7) RUN(8, PH8) RUN(9, PH9) RUN(10, PH10) RUN(11, PH11)
}

extern "C" void kernel_launch(void* const* d_in, const int* in_sizes, int n_in, void* d_out, int out_size, void* d_ws, size_t ws_size, hipStream_t stream) {
    static int grid = 0;
    if (grid == 0) {
        if (n_in != 23 || in_sizes[0] != MP * D || (size_t)out_size != OUT_END || ws_size < WS_END) { fprintf(stderr, "kernel_launch: unexpected shapes (n_in %d, in0 %d, out %d, ws %zu)\n", n_in, n_in > 0 ? in_sizes[0] : -1, out_size, ws_size); grid = -1; return; }
        int dev = 0, cus = 0, per_cu = 0;
        if (hipGetDevice(&dev) != hipSuccess || hipDeviceGetAttribute(&cus, hipDeviceAttributeMultiprocessorCount, dev) != hipSuccess) { grid = -1; return; }
        if (hipFuncSetAttribute((const void*)fwd_kernel, hipFuncAttributeMaxDynamicSharedMemorySize, LDS_BYTES) != hipSuccess) { fprintf(stderr, "kernel_launch: hipFuncSetAttribute failed\n"); grid = -1; return; }
        if (hipOccupancyMaxActiveBlocksPerMultiprocessor(&per_cu, (const void*)fwd_kernel, NWAVES * 64, LDS_BYTES) != hipSuccess || per_cu < 1) { fprintf(stderr, "kernel_launch: occupancy query says %d blocks per CU\n", per_cu); (void)hipGetLastError(); grid = -1; return; }
        grid = cus * per_cu;
    }
    if (grid < 0) return;
    (void)hipMemsetAsync((char*)d_ws + WS_CTL, 0, 65536, stream);
    Args a{};
    for (int i = 0; i < 23; ++i) a.in[i] = (const float*)d_in[i];
    a.out = (float*)d_out; a.ws = (unsigned char*)d_ws;
#if MK_N_LAUNCHES == 1
    a.prog = PROG;
    void* kargs[] = {&a};
    hipError_t e = hipLaunchCooperativeKernel((const void*)fwd_kernel, dim3(grid), dim3(NWAVES * 64), kargs, LDS_BYTES, stream);
    if (e != hipSuccess) fprintf(stderr, "cooperative launch failed: %s (grid %d)\n", hipGetErrorString(e), grid);
#else
#error multi-launch build removed
#endif
}
```

```cpp
#include <hip/hip_runtime.h>
#include <hip/hip_cooperative_groups.h>
#include <cstdio>
#include <cstdint>
namespace cg = cooperative_groups;

constexpr int D = 1024, SEQ = 2048, NB = 8, DB = 128, DS = 8;
constexpr int MP = NB * SEQ;
constexpr int MS = DB * DS;
constexpr int M = MP + MS;
constexpr int PW = 512, HW = 512, NH = 4, DK = 128, DV = 128, PBUF = 15;
constexpr int FF = 2816, PD = 256, NIN = 4608;
constexpr float EPS = 1e-6f;

namespace pg8 {
#define PG8_LAS __attribute__((address_space(3)))
typedef unsigned short bf16_t;
typedef short bf16x8 __attribute__((ext_vector_type(8)));
typedef float f32x4 __attribute__((ext_vector_type(4)));
typedef float f32x2 __attribute__((ext_vector_type(2)));
typedef unsigned u32x4 __attribute__((ext_vector_type(4)));
typedef unsigned u32x2 __attribute__((ext_vector_type(2)));
constexpr int BM = 256, BK = 64, HALF = 128, HTB = HALF * BK * 2  , STAGE_BYTES = 8 * HTB, NXCD = 8, WGM = 8;

__host__ __device__ __forceinline__ int lds_byte(int r, int c) { const int st = (r >> 4) * 2 + (c >> 5), rr = r & 15, cc = c & 31, ob = rr * 64 + cc * 2; return st * 1024 + (ob ^ (((ob >> 9) & 1) << 5)); }
__host__ __device__ __forceinline__ void stage_rc(int b, int& R, int& C) { const int st = b / 1024, sb = b % 1024, swz = sb ^ (((sb >> 9) & 1) << 5); R = (st >> 1) * 16 + swz / 64; C = (st & 1) * 32 + (swz % 64) / 2; }
__host__ __device__ __forceinline__ int perm32(int rho) { const int n = rho >> 4, i = rho & 15; return 8 * (i >> 2) + 4 * n + (i & 3); }

struct Unit { int pm, pn; };
struct Gemm { const bf16_t* A; const bf16_t* Bt; int M, N, K, lda, ldb; };

struct StaticOrder {
    int nM, nN, nwg, G, c;
    __host__ __device__ void init(int M_, int N_, int G_, int c_) { nM = M_ / BM; nN = N_ / BM; nwg = nM * nN; G = G_; c = c_; }
    __host__ __device__ bool next(int i, Unit& u) const {
        const long L = (long)i * G + c; if (L >= nwg) return false;
        int wgid = (int)L; { const int q = nwg / NXCD, r = nwg % NXCD, xcd = wgid % NXCD, off = wgid / NXCD; wgid = (xcd < r ? xcd * (q + 1) : r * (q + 1) + (xcd - r) * q) + off; }
        const int nig = WGM * nN, gid = wgid / nig, fm = gid * WGM, gsz = (nM - fm) < WGM ? (nM - fm) : WGM;
        u.pm = fm + ((wgid % nig) % gsz); u.pn = (wgid % nig) / gsz; return true;
    }
    __device__ __forceinline__ void a_ready(const Unit&) const {}
    __device__ __forceinline__ void done(const Unit&) const {}
};

typedef __bf16 bf16x2_hw __attribute__((ext_vector_type(2)));
__device__ __forceinline__ unsigned cvt_pk_bf16(float lo, float hi) { const f32x2 v = {lo, hi}; return __builtin_bit_cast(unsigned, __builtin_convertvector(v, bf16x2_hw)); }

template <class Epi, class Sched, bool ALIGN_EPI>
__device__ __forceinline__ void gemm_phase(PG8_LAS unsigned char* lds, const Gemm g, const Sched& S, const Epi& E) {
    const int tid = threadIdx.x, wid = __builtin_amdgcn_readfirstlane(tid >> 6), lane = tid & 63, wr = wid >> 2, wc = wid & 3, fr = lane & 15, fq = lane >> 4;
    int nt = g.K / BK; asm volatile("" : "+s"(nt));
    unsigned voffA[2], voffB[2];
#pragma unroll
    for (int i = 0; i < 2; ++i) { int R, C; stage_rc(tid * 16 + i * 8192, R, C); const int Rb = Epi::PERM ? ((R & ~31) + perm32(R & 31)) : R;
        voffA[i] = (unsigned)(R * g.lda + C) * 2u; voffB[i] = (unsigned)(Rb * g.ldb + C) * 2u; }
    const size_t kstep = (size_t)(BK * 2);
    const size_t hstepA = (size_t)HALF * g.lda * 2, hstepB = (size_t)HALF * g.ldb * 2;
    const size_t tstepA = 2 * hstepA, tstepB = 2 * hstepB;
    const unsigned ldsw = (unsigned)wid * 1024u;
    const int aoff = lds_byte(wr * 64 + fr, fq * 8), boff = lds_byte(wc * 32 + fr, fq * 8);
#define PG8_SA(b, h) (((b) * 2 + (h)) * HTB)
#define PG8_SB(b, h) ((4 + (b) * 2 + (h)) * HTB)
#define PG8_STAGE(bufoff, gbase, voff) do { _Pragma("unroll") for (int _i = 0; _i < 2; ++_i) \
        __builtin_amdgcn_global_load_lds((const unsigned*)((const char*)(gbase) + (voff)[_i]), (PG8_LAS unsigned*)(lds + (bufoff) + ldsw + _i * 8192), 16, 0, 0); } while (0)
#define PG8_LDA(dst, b, h) do { _Pragma("unroll") for (int m = 0; m < 4; ++m) _Pragma("unroll") for (int k = 0; k < 2; ++k) dst[m][k] = *(const PG8_LAS bf16x8*)(lds + PG8_SA(b, h) + aoff + m * 2048 + k * 1024); } while (0)
#define PG8_LDB(dst, b, h) do { _Pragma("unroll") for (int n = 0; n < 2; ++n) _Pragma("unroll") for (int k = 0; k < 2; ++k) dst[n][k] = *(const PG8_LAS bf16x8*)(lds + PG8_SB(b, h) + boff + n * 2048 + k * 1024); } while (0)
#define PG8_MMA(ai, bj, At, Bt) do { __builtin_amdgcn_s_setprio(1); _Pragma("unroll") for (int m = 0; m < 4; ++m) _Pragma("unroll") for (int n = 0; n < 2; ++n) _Pragma("unroll") for (int k = 0; k < 2; ++k) \
        acc[ai][bj][m][n] = __builtin_amdgcn_mfma_f32_16x16x32_bf16(Bt[n][k], At[m][k], acc[ai][bj][m][n], 0, 0, 0); __builtin_amdgcn_s_setprio(0); } while (0)
#define PG8_WAIT_V(n) asm volatile("s_waitcnt vmcnt(" #n ")" ::: "memory")
#define PG8_WAIT_L(n) asm volatile("s_waitcnt lgkmcnt(" #n ")" ::: "memory")
#define PG8_BAR __builtin_amdgcn_s_barrier()
#define PG8_SCHED __builtin_amdgcn_sched_barrier(0)
    Unit cur, nxt; int ui = 0;
    if (!S.next(0, cur)) return;
    f32x4 acc[2][2][4][2];
#pragma unroll
    for (int a = 0; a < 2; ++a)
#pragma unroll
        for (int b = 0; b < 2; ++b)
#pragma unroll
            for (int m = 0; m < 4; ++m)
#pragma unroll
                for (int n = 0; n < 2; ++n) acc[a][b][m][n] = (f32x4){0.f, 0.f, 0.f, 0.f};
    bf16x8 At[4][2], B0[2][2], B1[2][2];
    const char* cA = (const char*)g.A + (size_t)cur.pm * tstepA; const char* cB = (const char*)g.Bt + (size_t)cur.pn * tstepB;
    S.a_ready(cur);
    PG8_STAGE(PG8_SB(0, 0), cB, voffB); PG8_STAGE(PG8_SB(0, 1), cB + hstepB, voffB); PG8_STAGE(PG8_SA(0, 0), cA, voffA); PG8_STAGE(PG8_SA(0, 1), cA + hstepA, voffA);
    if (wr == 1) PG8_BAR;
    PG8_WAIT_V(2); PG8_BAR;
    PG8_STAGE(PG8_SB(1, 0), cB + kstep, voffB); PG8_STAGE(PG8_SA(1, 0), cA + kstep, voffA); PG8_STAGE(PG8_SB(1, 1), cB + hstepB + kstep, voffB);
    PG8_WAIT_V(6); PG8_BAR;
    for (;;) {
        const bool has_next = S.next(ui + 1, nxt);
        const char* nA = has_next ? (const char*)g.A + (size_t)nxt.pm * tstepA : cA; const char* nB = has_next ? (const char*)g.Bt + (size_t)nxt.pn * tstepB : cB;
        for (int t = 0; t < nt; t += 2) {
            const bool last = (t == nt - 2);
            const char* a1 = cA + (size_t)(t + 1) * kstep;
            const char* a2 = last ? nA : cA + (size_t)(t + 2) * kstep; const char* b2 = last ? nB : cB + (size_t)(t + 2) * kstep;
            const char* a3 = a2 + kstep; const char* b3 = b2 + kstep;
            if (last && has_next) S.a_ready(nxt);
            PG8_LDB(B0, 0, 0); PG8_LDB(B1, 0, 1); PG8_SCHED; PG8_LDA(At, 0, 0); PG8_STAGE(PG8_SA(1, 1), a1 + hstepA, voffA);
            PG8_WAIT_V(8); PG8_WAIT_L(0); PG8_BAR; PG8_MMA(0, 0, At, B0); PG8_MMA(0, 1, At, B1); PG8_BAR; PG8_SCHED;
            PG8_LDA(At, 0, 1); PG8_STAGE(PG8_SB(0, 0), b2, voffB); PG8_STAGE(PG8_SB(0, 1), b2 + hstepB, voffB); PG8_STAGE(PG8_SA(0, 0), a2, voffA);
            PG8_WAIT_V(8); PG8_WAIT_L(0); PG8_BAR; PG8_MMA(1, 0, At, B0); PG8_MMA(1, 1, At, B1); PG8_BAR; PG8_SCHED;
            PG8_LDB(B0, 1, 0); PG8_LDB(B1, 1, 1); PG8_SCHED; PG8_LDA(At, 1, 0); PG8_STAGE(PG8_SA(0, 1), a2 + hstepA, voffA);
            PG8_WAIT_V(8); PG8_WAIT_L(0); PG8_BAR; PG8_MMA(0, 0, At, B0); PG8_MMA(0, 1, At, B1); PG8_BAR; PG8_SCHED;
            PG8_LDA(At, 1, 1); PG8_STAGE(PG8_SB(1, 0), b3, voffB); PG8_STAGE(PG8_SB(1, 1), b3 + hstepB, voffB); PG8_STAGE(PG8_SA(1, 0), a3, voffA);
            PG8_WAIT_V(8); PG8_WAIT_L(0); PG8_BAR; PG8_MMA(1, 0, At, B0); PG8_MMA(1, 1, At, B1); PG8_BAR; PG8_SCHED;
        }
        if constexpr (ALIGN_EPI) { if (wr == 0) PG8_BAR; }
        E(acc, cur, wr, wc, fr, fq); S.done(cur);
        if (!has_next) break;
#pragma unroll
        for (int a = 0; a < 2; ++a)
#pragma unroll
            for (int b = 0; b < 2; ++b)
#pragma unroll
                for (int m = 0; m < 4; ++m)
#pragma unroll
                    for (int n = 0; n < 2; ++n) acc[a][b][m][n] = (f32x4){0.f, 0.f, 0.f, 0.f};
        cur = nxt; cA = nA; cB = nB; ++ui;
        if constexpr (ALIGN_EPI) { if (wr == 1) PG8_BAR; }
    }
    PG8_WAIT_V(0);
    if constexpr (!ALIGN_EPI) { if (wr == 0) PG8_BAR; }
    PG8_BAR;
#undef PG8_SA
#undef PG8_SB
#undef PG8_STAGE
#undef PG8_LDA
#undef PG8_LDB
#undef PG8_MMA
#undef PG8_WAIT_V
#undef PG8_WAIT_L
#undef PG8_BAR
#undef PG8_SCHED
}
}

namespace pg8 {
__device__ __forceinline__ float sigm(float x) { return __builtin_amdgcn_rcpf(1.0f + __builtin_amdgcn_exp2f(-1.4426950408889634f * x)); }
__device__ __forceinline__ float silu(float x) { return x * sigm(x); }
__device__ __forceinline__ float bf_lo(unsigned w) { return __uint_as_float(w << 16); }
__device__ __forceinline__ float bf_hi(unsigned w) { return __uint_as_float(w & 0xffff0000u); }
__device__ __forceinline__ u32x4 pack8(const f32x4 a, const f32x4 b) { u32x4 w; w.x = cvt_pk_bf16(a[0], a[1]); w.y = cvt_pk_bf16(a[2], a[3]); w.z = cvt_pk_bf16(b[0], b[1]); w.w = cvt_pk_bf16(b[2], b[3]); return w; }
__device__ __forceinline__ void unpack8(const u32x4 w, f32x4& a, f32x4& b) { a = (f32x4){bf_lo(w.x), bf_hi(w.x), bf_lo(w.y), bf_hi(w.y)}; b = (f32x4){bf_lo(w.z), bf_hi(w.z), bf_lo(w.w), bf_hi(w.w)}; }

template <int N> __device__ __forceinline__ float row_shr(float x) {
    return __int_as_float(__builtin_amdgcn_update_dpp(0, __float_as_int(x), 0x110 + N, 0xf, 0xf, false));
}
__device__ __forceinline__ float row_scan16(float x) { x += row_shr<1>(x); x += row_shr<2>(x); x += row_shr<4>(x); x += row_shr<8>(x); return x; }
__device__ __forceinline__ float row_last(float x) { return __shfl(x, 15, 16); }

struct EpiIn {
    static constexpr bool PERM = true;
    float* U; bf16_t* QE; bf16_t* KE; bf16_t* KDT; float* DEC; float* FG; bf16_t* Vb; bf16_t* VT; bf16_t* SG; bf16_t* GA; bf16_t* GB; const float* rstd; const float* lb;
    __device__ __forceinline__ void operator()(const f32x4 (&acc)[2][2][4][2], const Unit& u, int wr, int wc, int fr, int fq) const {
        const int pn = u.pn, row0 = u.pm * BM + wr * 64 + fr, cl = wc * 32 + 8 * fq;
        if (pn >= 2 && pn < 6) {
            const int h = pn - 2, kc = h * 128 + cl;
            if (u.pm < 64) {
#pragma unroll
                for (int ai = 0; ai < 2; ++ai) {
                    const int chunk = u.pm * 4 + ai * 2 + wr;
                    float rr[4];
#pragma unroll
                    for (int m = 0; m < 4; ++m) rr[m] = rstd[row0 + ai * HALF + m * 16];
#pragma unroll
                    for (int n = 0; n < 2; ++n) {
                        const f32x4 lbv = *(const f32x4*)(lb + kc + 4 * n);
                        f32x4 qe[4], ke[4], dcy;
#pragma unroll
                        for (int e = 0; e < 4; ++e) {
                            float q[4], k1[4], G[4]; float carry = 0.f;
#pragma unroll
                            for (int m = 0; m < 4; ++m) {
                                q[m] = silu(acc[ai][0][m][n][e] * rr[m]);
                                const float fg = lbv[e] + (1.0f - lbv[e]) * sigm(acc[ai][1][m][n][e] * rr[m]);
                                k1[m] = 1.0f - fg;
                                const float x = row_scan16(__logf(fg));
                                G[m] = x + carry; carry += row_last(x);
                            }
                            dcy[e] = __expf(carry);
#pragma unroll
                            for (int m = 0; m < 4; ++m) {
                                qe[m][e] = q[m] * __expf(G[m]);
                                ke[m][e] = k1[m] * __expf(fminf(-G[m], 80.0f));
                                const float kd = k1[m] * __expf(carry - G[m]);
                                KDT[((size_t)chunk * 512 + kc + 4 * n + e) * 64 + m * 16 + fr] = (bf16_t)(cvt_pk_bf16(kd, 0.f) & 0xffffu);
                            }
                        }
#pragma unroll
                        for (int m = 0; m < 4; ++m) {
                            const size_t off = (size_t)(row0 + ai * HALF + m * 16) * 512 + kc + 4 * n;
                            u32x2 wq; wq.x = cvt_pk_bf16(qe[m][0], qe[m][1]); wq.y = cvt_pk_bf16(qe[m][2], qe[m][3]); *(u32x2*)(QE + off) = wq;
                            u32x2 wk; wk.x = cvt_pk_bf16(ke[m][0], ke[m][1]); wk.y = cvt_pk_bf16(ke[m][2], ke[m][3]); *(u32x2*)(KE + off) = wk;
                        }
                        if (fr == 0) *(f32x4*)(DEC + (size_t)chunk * 512 + kc + 4 * n) = dcy;
                    }
                }
            } else {
                f32x4 l0 = *(const f32x4*)(lb + kc), l1 = *(const f32x4*)(lb + kc + 4);
#pragma unroll
                for (int ai = 0; ai < 2; ++ai)
#pragma unroll
                    for (int m = 0; m < 4; ++m) {
                        const int row = row0 + ai * HALF + m * 16; const float r = rstd[row];
                        f32x4 q0 = acc[ai][0][m][0] * r, q1 = acc[ai][0][m][1] * r, f0 = acc[ai][1][m][0] * r, f1 = acc[ai][1][m][1] * r;
#pragma unroll
                        for (int e = 0; e < 4; ++e) { q0[e] = silu(q0[e]); q1[e] = silu(q1[e]); f0[e] = l0[e] + (1.0f - l0[e]) * sigm(f0[e]); f1[e] = l1[e] + (1.0f - l1[e]) * sigm(f1[e]); }
                        const size_t off = (size_t)row * 512 + kc;
                        *(u32x4*)(QE + off) = pack8(q0, q1); *(f32x4*)(FG + off) = f0; *(f32x4*)(FG + off + 4) = f1;
                    }
            }
            return;
        }
        int kind, ld, colt; float* df = nullptr; bf16_t* db = nullptr;
        if (pn < 2)       { kind = 0; df = U;  ld = 512;  colt = 256 * pn; }
        else if (pn < 8)  { kind = 2; db = Vb; ld = 512;  colt = 256 * (pn - 6); }
        else if (pn < 10) { kind = 3; db = SG; ld = 512;  colt = 256 * (pn - 8); }
        else if (pn < 14) { kind = 4; db = GA; ld = 1024; colt = 256 * (pn - 10); }
        else              { kind = 4; db = GB; ld = 1024; colt = 256 * (pn - 14); }
        const int c0 = colt + cl;
        const bool vtr = (kind == 2) && (u.pm < 64);
#pragma unroll
        for (int ai = 0; ai < 2; ++ai)
#pragma unroll
            for (int m = 0; m < 4; ++m) {
                const int row = row0 + ai * HALF + m * 16; const float r = rstd[row];
#pragma unroll
                for (int bj = 0; bj < 2; ++bj) {
                    f32x4 v0 = acc[ai][bj][m][0] * r, v1 = acc[ai][bj][m][1] * r;
                    const size_t off = (size_t)row * ld + c0 + bj * HALF;
                    if (kind == 0) { *(f32x4*)(df + off) = v0; *(f32x4*)(df + off + 4) = v1; }
                    else {
                        if (kind == 3) {
#pragma unroll
                            for (int e = 0; e < 4; ++e) { v0[e] = silu(v0[e]); v1[e] = silu(v1[e]); }
                        } else if (kind == 4) {
#pragma unroll
                            for (int e = 0; e < 4; ++e) { v0[e] = sigm(v0[e]); v1[e] = sigm(v1[e]); }
                        }
                        const u32x4 w = pack8(v0, v1);
                        *(u32x4*)(db + off) = w;
                        if (vtr) {
                            bf16_t* vt = VT + ((size_t)(u.pm * 4 + ai * 2 + wr) * 512 + c0 + bj * HALF) * 64 + m * 16 + fr;
                            vt[0 * 64] = (bf16_t)(w.x & 0xffffu); vt[1 * 64] = (bf16_t)(w.x >> 16); vt[2 * 64] = (bf16_t)(w.y & 0xffffu); vt[3 * 64] = (bf16_t)(w.y >> 16);
                            vt[4 * 64] = (bf16_t)(w.z & 0xffffu); vt[5 * 64] = (bf16_t)(w.z >> 16); vt[6 * 64] = (bf16_t)(w.w & 0xffffu); vt[7 * 64] = (bf16_t)(w.w >> 16);
                        }
                    }
                }
            }
    }
};

struct EpiGateA {
    static constexpr bool PERM = true;
    float* T; const bf16_t* GA;
    __device__ __forceinline__ void operator()(const f32x4 (&acc)[2][2][4][2], const Unit& u, int wr, int wc, int fr, int fq) const {
        const int row0 = u.pm * BM + wr * 64 + fr, c0 = u.pn * BM + wc * 32 + 8 * fq;
#pragma unroll
        for (int ai = 0; ai < 2; ++ai)
#pragma unroll
            for (int m = 0; m < 4; ++m) {
                const int row = row0 + ai * HALF + m * 16;
#pragma unroll
                for (int bj = 0; bj < 2; ++bj) {
                    const size_t off = (size_t)row * 1024 + c0 + bj * HALF;
                    f32x4 g0, g1; unpack8(*(const u32x4*)(GA + off), g0, g1);
                    *(f32x4*)(T + off) = acc[ai][bj][m][0] * g0; *(f32x4*)(T + off + 4) = acc[ai][bj][m][1] * g1;
                }
            }
    }
};
struct EpiGateB {
    static constexpr bool PERM = true;
    const float* T; const bf16_t* GB; bf16_t* MG;
    __device__ __forceinline__ void operator()(const f32x4 (&acc)[2][2][4][2], const Unit& u, int wr, int wc, int fr, int fq) const {
        const int row0 = u.pm * BM + wr * 64 + fr, c0 = u.pn * BM + wc * 32 + 8 * fq;
#pragma unroll
        for (int ai = 0; ai < 2; ++ai)
#pragma unroll
            for (int m = 0; m < 4; ++m) {
                const int row = row0 + ai * HALF + m * 16;
#pragma unroll
                for (int bj = 0; bj < 2; ++bj) {
                    const size_t off = (size_t)row * 1024 + c0 + bj * HALF;
                    f32x4 g0, g1; unpack8(*(const u32x4*)(GB + off), g0, g1);
                    const f32x4 t0 = *(const f32x4*)(T + off), t1 = *(const f32x4*)(T + off + 4);
                    *(u32x4*)(MG + off) = pack8(t0 + acc[ai][bj][m][0] * g0, t1 + acc[ai][bj][m][1] * g1);
                }
            }
    }
};
struct EpiRes {
    static constexpr bool PERM = true;
    const float* base_lo; const float* base_hi; float* out; bf16_t* outb; float* ssq;
    __device__ __forceinline__ void operator()(const f32x4 (&acc)[2][2][4][2], const Unit& u, int wr, int wc, int fr, int fq) const {
        const int row0 = u.pm * BM + wr * 64 + fr, c0 = u.pn * BM + wc * 32 + 8 * fq;
        const float* base = (u.pm < 64) ? base_lo : base_hi;
#pragma unroll
        for (int ai = 0; ai < 2; ++ai)
#pragma unroll
            for (int m = 0; m < 4; ++m) {
                const int row = row0 + ai * HALF + m * 16; float s = 0.f;
#pragma unroll
                for (int bj = 0; bj < 2; ++bj) {
                    const size_t off = (size_t)row * 1024 + c0 + bj * HALF;
                    const f32x4 v0 = *(const f32x4*)(base + off) + acc[ai][bj][m][0], v1 = *(const f32x4*)(base + off + 4) + acc[ai][bj][m][1];
                    *(f32x4*)(out + off) = v0; *(f32x4*)(out + off + 4) = v1;
                    *(u32x4*)(outb + off) = pack8(v0, v1);
                    s += (v0[0] * v0[0] + v0[1] * v0[1]) + (v0[2] * v0[2] + v0[3] * v0[3]) + (v1[0] * v1[0] + v1[1] * v1[1]) + (v1[2] * v1[2] + v1[3] * v1[3]);
                }
                s += __shfl_xor(s, 16); s += __shfl_xor(s, 32);
                if (fq == 0) unsafeAtomicAdd(ssq + row, s);
                if (m & 1) asm volatile("" ::: "memory");
            }
    }
};
struct EpiSwiGLU {
    static constexpr bool PERM = true;
    bf16_t* ACT; const float* ssq;
    __device__ __forceinline__ void operator()(const f32x4 (&acc)[2][2][4][2], const Unit& u, int wr, int wc, int fr, int fq) const {
        const int row0 = u.pm * BM + wr * 64 + fr, c0 = u.pn * HALF + wc * 32 + 8 * fq;
#pragma unroll
        for (int ai = 0; ai < 2; ++ai)
#pragma unroll
            for (int m = 0; m < 4; ++m) {
                const int row = row0 + ai * HALF + m * 16; const float r = __builtin_amdgcn_rsqf(ssq[row] * (1.0f / 1024.0f) + EPS);
                f32x4 a0 = acc[ai][0][m][0] * r, a1 = acc[ai][0][m][1] * r; const f32x4 u0 = acc[ai][1][m][0] * r, u1 = acc[ai][1][m][1] * r;
#pragma unroll
                for (int e = 0; e < 4; ++e) { a0[e] = silu(a0[e]) * u0[e]; a1[e] = silu(a1[e]) * u1[e]; }
                *(u32x4*)(ACT + (size_t)row * FF + c0) = pack8(a0, a1);
            }
    }
};
struct EpiBf {
    static constexpr bool PERM = true;
    bf16_t* O;
    __device__ __forceinline__ void operator()(const f32x4 (&acc)[2][2][4][2], const Unit& u, int wr, int wc, int fr, int fq) const {
        const int row0 = u.pm * BM + wr * 64 + fr, c0 = u.pn * BM + wc * 32 + 8 * fq;
#pragma unroll
        for (int ai = 0; ai < 2; ++ai)
#pragma unroll
            for (int m = 0; m < 4; ++m) {
                const int row = row0 + ai * HALF + m * 16;
#pragma unroll
                for (int bj = 0; bj < 2; ++bj) *(u32x4*)(O + (size_t)row * 1024 + c0 + bj * HALF) = pack8(acc[ai][bj][m][0], acc[ai][bj][m][1]);
            }
    }
};
struct EpiPle {
    static constexpr bool PERM = true;
    float* X; const bf16_t* EMB; const float* ssq_in; float* ssq_out;
    __device__ __forceinline__ void operator()(const f32x4 (&acc)[2][2][4][2], const Unit& u, int wr, int wc, int fr, int fq) const {
        const int row0 = u.pm * BM + wr * 64 + fr, c0 = u.pn * BM + wc * 32 + 8 * fq;
#pragma unroll
        for (int ai = 0; ai < 2; ++ai)
#pragma unroll
            for (int m = 0; m < 4; ++m) {
                const int row = row0 + ai * HALF + m * 16; const float r = __builtin_amdgcn_rsqf(ssq_in[row] * (1.0f / 1024.0f) + EPS); float s = 0.f;
#pragma unroll
                for (int bj = 0; bj < 2; ++bj) {
                    const size_t off = (size_t)row * 1024 + c0 + bj * HALF;
                    f32x4 e0, e1; unpack8(*(const u32x4*)(EMB + off), e0, e1);
                    f32x4 v0 = *(const f32x4*)(X + off), v1 = *(const f32x4*)(X + off + 4);
#pragma unroll
                    for (int e = 0; e < 4; ++e) { v0[e] += sigm(acc[ai][bj][m][0][e] * r) * e0[e]; v1[e] += sigm(acc[ai][bj][m][1][e] * r) * e1[e]; }
                    *(f32x4*)(X + off) = v0; *(f32x4*)(X + off + 4) = v1;
                    s += (v0[0] * v0[0] + v0[1] * v0[1]) + (v0[2] * v0[2] + v0[3] * v0[3]) + (v1[0] * v1[0] + v1[1] * v1[1]) + (v1[2] * v1[2] + v1[3] * v1[3]);
                }
                s += __shfl_xor(s, 16); s += __shfl_xor(s, 32);
                if (fq == 0) unsafeAtomicAdd(ssq_out + row, s);
                if (m & 1) asm volatile("" ::: "memory");
            }
    }
};
}

constexpr int NWAVES = 8;
constexpr size_t MiB = 1u << 20;
constexpr size_t WS_CTL = 0, CTL_ZERO_BYTES = 1 * MiB;
constexpr size_t WS_SMALL = 1 * MiB;
constexpr size_t SM_LB = 0, SM_RSTD0 = 4096, SM_SSQ1 = SM_RSTD0 + 69632 * 1, SM_SSQ2 = SM_SSQ1 + 69632, SM_SSQ3 = SM_SSQ2 + 69632;
constexpr size_t WS_WIN = 2 * MiB;
constexpr size_t WS_WAB = 11 * MiB;
constexpr size_t WS_WOUT = 13 * MiB;
constexpr size_t WS_WGU = 15 * MiB;
constexpr size_t WS_WDN = 26 * MiB;
constexpr size_t WS_WPG = 32 * MiB;
constexpr size_t WS_WPP = 34 * MiB;
constexpr size_t WS_PB = 35 * MiB;
constexpr size_t WS_XB = 44 * MiB;
constexpr size_t WS_QB = 78 * MiB;
constexpr size_t WS_VB = 95 * MiB;
constexpr size_t WS_SG = 112 * MiB;
constexpr size_t WS_GA = 129 * MiB;
constexpr size_t WS_GB = 163 * MiB;
constexpr size_t WS_O = 197 * MiB;
constexpr size_t WS_KE = 197 * MiB, WS_KDT = 214 * MiB;
constexpr size_t WS_ACT = 78 * MiB;
constexpr size_t WS_END = 232 * MiB;
static_assert(WS_ACT + (size_t)M * FF * 2 <= WS_O, "act overlay");
static_assert(WS_WDN + (size_t)D * FF * 2 <= WS_WPG && WS_WPP + (size_t)D * PD * 2 <= WS_PB && WS_PB + (size_t)M * PD * 2 <= WS_XB && WS_XB + (size_t)M * D * 2 <= WS_QB, "ws map");
static_assert(WS_GB + (size_t)M * D * 2 <= WS_O && WS_O + (size_t)M * PW * 4 <= WS_END, "ws map 2");
constexpr size_t OUT_Y = 0, OUT_NPP = (size_t)M * D, OUT_NHP = OUT_NPP + (size_t)NB * PBUF * PW, OUT_NPS = OUT_NHP + (size_t)NB * NH * DK * DV, OUT_NHS = OUT_NPS + (size_t)DB * PBUF * PW,
                 OUT_END = OUT_NHS + (size_t)DB * NH * DK * DV;

constexpr int RING_BYTES = 131072, MISC_OFF = RING_BYTES, LDS_BYTES = 147456;

#define LAS __attribute__((address_space(3)))
typedef unsigned short bf16;
typedef unsigned v4u __attribute__((ext_vector_type(4)));
typedef unsigned v2u __attribute__((ext_vector_type(2)));
typedef float f32x4 __attribute__((ext_vector_type(4)));
#define LDS_WAIT() asm volatile("s_waitcnt lgkmcnt(0)" ::: "memory")
__device__ __forceinline__ unsigned pk2(float lo, float hi) { return pg8::cvt_pk_bf16(lo, hi); }
__device__ __forceinline__ float bf2f(bf16 v) { return __uint_as_float((unsigned)v << 16); }
__device__ __forceinline__ float wave_sum(float v) {
#pragma unroll
    for (int o = 1; o < 64; o <<= 1) v += __shfl_xor(v, o);
    return v;
}

#define XB_TMO      128
#define XB_XCNT(j)  (256  + 64 * (j))
#define XB_XSUB(j)  (1280 + 64 * (j))
#define XB_XGEN(j)  (2304 + 64 * (j))
#define XB_TOP      3328
#define XB_TOPGEN   3392
#define XCD_BAR_WORDS 3456
#define XB_SPIN_CAP (1u << 18)

__device__ __forceinline__ unsigned xb_ld(unsigned* p)              { return __hip_atomic_load(p, __ATOMIC_RELAXED, __HIP_MEMORY_SCOPE_AGENT); }
__device__ __forceinline__ unsigned xb_add(unsigned* p, unsigned v) { return __hip_atomic_fetch_add(p, v, __ATOMIC_RELAXED, __HIP_MEMORY_SCOPE_AGENT); }
__device__ __forceinline__ unsigned xb_xcc_id() { return (unsigned)__builtin_amdgcn_s_getreg((3 << 11) | 20) & 0xFu; }
#define XB_SPIN(cond, bar) do { unsigned _sp = 0; while (cond) { __builtin_amdgcn_s_sleep(1); \
    if ((++_sp & 255u) == 0u) { if (xb_ld(&(bar)[XB_TMO])) break; if (_sp > XB_SPIN_CAP) { atomicAdd(&(bar)[XB_TMO], 1u); break; } } } } while (0)

struct XcdBarrier {
    unsigned* bar; unsigned x;
    volatile LAS unsigned* st;
};

__device__ __forceinline__ XcdBarrier xcd_barrier_post(unsigned* bar, volatile LAS unsigned* st) {
    XcdBarrier b; b.bar = bar; b.x = xb_xcc_id(); b.st = st;
    if (threadIdx.x == 0) (void)xb_add(&bar[XB_XCNT(b.x)], 1u);
    return b;
}
__device__ __forceinline__ void xcd_barrier_complete(unsigned* bar, unsigned x, unsigned& nloc, unsigned& nx) {
    const unsigned G = gridDim.x * gridDim.y * gridDim.z;
    unsigned sum, cnt, mine, sp = 0u;
    for (;;) {
        sum = 0u; cnt = 0u; mine = 0u;
#pragma unroll
        for (unsigned j = 0; j < 16; ++j) { const unsigned c = xb_ld(&bar[XB_XCNT(j)]); sum += c; cnt += (c > 0u) ? 1u : 0u; mine = (j == x) ? c : mine; }
        if (sum == G) break;
        __builtin_amdgcn_s_sleep(1);
        if ((++sp & 255u) == 0u) { if (xb_ld(&bar[XB_TMO])) break; if (sp > XB_SPIN_CAP) { atomicAdd(&bar[XB_TMO], 1u); break; } }
    }
    nloc = mine > 0u ? mine : 1u; nx = cnt > 0u ? cnt : 1u;
}

__device__ __forceinline__ void xcd_barrier(const XcdBarrier& b) {
    asm volatile("s_waitcnt vmcnt(0)" ::: "memory");
    __syncthreads();
    if (threadIdx.x == 0) {
        unsigned* bar = b.bar;
        __builtin_amdgcn_s_waitcnt(0);
        unsigned nloc = b.st[0], nx = b.st[1];
        if (nloc == 0u) { xcd_barrier_complete(bar, b.x, nloc, nx); b.st[0] = nloc; b.st[1] = nx; }
        const unsigned old = xb_add(&bar[XB_XSUB(b.x)], 1u);
        const unsigned gen = old / nloc;
        if (old + 1u == (gen + 1u) * nloc) {
            __builtin_amdgcn_fence(__ATOMIC_RELEASE, "agent");
            asm volatile("s_waitcnt vmcnt(0)" ::: "memory");
            const unsigned og = xb_add(&bar[XB_TOP], 1u);
            const unsigned tg = og / nx;
            if (og + 1u == (tg + 1u) * nx) xb_add(&bar[XB_TOPGEN], 1u);
            else XB_SPIN(xb_ld(&bar[XB_TOPGEN]) == tg, bar);
            __builtin_amdgcn_fence(__ATOMIC_ACQUIRE, "agent");
            xb_add(&bar[XB_XGEN(b.x)], 1u);
            asm volatile("s_waitcnt vmcnt(0)" ::: "memory");
        } else {
            XB_SPIN(xb_ld(&bar[XB_XGEN(b.x)]) == gen, bar);
            __builtin_amdgcn_fence(__ATOMIC_ACQUIRE, "agent");
            asm volatile("s_waitcnt vmcnt(0)" ::: "memory");
        }
    }
    __syncthreads();
}

struct Frame {
    LAS unsigned char* lds;
    int tid, lane, wave, G, wg;
    float* out; unsigned char* ws;
};
struct Args { const float* in[23]; float* out; unsigned char* ws; unsigned long long prog; };
static_assert(sizeof(Args) == 23 * 8 + 8 + 8 + 8, "Args has no padding");
enum { I_XP = 0, I_XS, I_SPOOL, I_SHGRN, I_PP, I_PS, I_GMIX, I_WIN, I_WPMIX, I_PSCALE, I_HLB, I_HNORM, I_WPUP, I_WHUP, I_WOUT, I_GFFN, I_WFG, I_WFU, I_WFD, I_GPLE, I_WPG, I_WPPJ, I_GFIN };

__device__ __forceinline__ void p0_transpose_item(const float* W, int N, const float* gain, bf16* WT, int ldk, int drow, int k0, int n0, int koff, LAS float* scr, int lane) {
#pragma unroll 8
    for (int i = 0; i < 32; ++i) { const int kk = 2 * i + (lane >> 5); float v = W[(size_t)(k0 + kk) * N + n0 + (lane & 31)]; if (gain) v *= gain[k0 + kk]; scr[kk * 33 + (lane & 31)] = v; }
    LDS_WAIT(); asm volatile("" ::: "memory");
    const int c = lane & 7;
#pragma unroll
    for (int j = 0; j < 4; ++j) { const int n = (lane >> 3) + 8 * j; const LAS float* s = scr + (8 * c) * 33 + n;
        v4u o; o.x = pk2(s[0 * 33], s[1 * 33]); o.y = pk2(s[2 * 33], s[3 * 33]); o.z = pk2(s[4 * 33], s[5 * 33]); o.w = pk2(s[6 * 33], s[7 * 33]);
        *(v4u*)(WT + (size_t)(drow + n) * ldk + koff + k0 + 8 * c) = o; }
    LDS_WAIT(); asm volatile("" ::: "memory");
}
__device__ __forceinline__ void p0_fold_item(const float* w_pool_mix, const float* w_pool_up, const float* pool_scale, bf16* WAB, int item, int lane) {
    const int g = item >> 7, cb = (item >> 4) & 7, nb = item & 15, n = nb * 64 + lane, c0 = cb * 16;
    float a[16];
#pragma unroll
    for (int c = 0; c < 16; ++c) a[c] = 0.f;
    const float* mix = w_pool_mix + (size_t)g * 128 * 128 + (size_t)c0 * 128;
    for (int d = 0; d < 128; ++d) {
        const float w = w_pool_up[(size_t)(g * 128 + d) * D + n] * pool_scale[g * 128 + d];
#pragma unroll
        for (int c = 0; c < 16; ++c) a[c] += mix[c * 128 + d] * w;
    }
    v4u o0, o1; o0.x = pk2(a[0], a[1]); o0.y = pk2(a[2], a[3]); o0.z = pk2(a[4], a[5]); o0.w = pk2(a[6], a[7]); o1.x = pk2(a[8], a[9]); o1.y = pk2(a[10], a[11]); o1.z = pk2(a[12], a[13]); o1.w = pk2(a[14], a[15]);
    bf16* dst = WAB + (size_t)n * 1024 + g * 128 + c0; *(v4u*)dst = o0; *(v4u*)(dst + 8) = o1;
}
template <int PART>
__device__ __forceinline__ void p0_prologue(const Frame& F, const Args& A, int wg0) {
    LAS float* scr = (LAS float*)(F.lds + F.wave * 16384);
    const int gw = (F.wg - wg0) * NWAVES + F.wave, NGW = (F.G - wg0) * NWAVES, lane = F.lane;
    unsigned char* ws = F.ws;
    bf16 *WIN = (bf16*)(ws + WS_WIN), *WAB = (bf16*)(ws + WS_WAB), *WOUT = (bf16*)(ws + WS_WOUT), *WGU = (bf16*)(ws + WS_WGU), *WDN = (bf16*)(ws + WS_WDN), *WPG = (bf16*)(ws + WS_WPG), *WPP = (bf16*)(ws + WS_WPP);
    constexpr int NI_IN = 16 * 144, NI_HU = 8 * 32, NI_OUT = 16 * 32, NI_G = 16 * 88, NI_DN = 44 * 32, NI_PG = 16 * 32, NI_PP = 4 * 32, NI_FOLD = 512;
    if constexpr (PART == 0) {
        for (int r = gw; r < NI_IN; r += NGW) { const int kb = r / 144, nb = r % 144, n0 = 32 * nb;
            const int drow = (n0 >= 512 && n0 < 1024) ? 512 + ((n0 - 512) >> 7) * 256 + ((n0 - 512) & 127) : (n0 >= 1024 && n0 < 1536) ? 512 + ((n0 - 1024) >> 7) * 256 + 128 + ((n0 - 1024) & 127) : n0;
            p0_transpose_item(A.in[I_WIN], NIN, A.in[I_GMIX], WIN, 1024, drow, 64 * kb, n0, 0, scr, lane); }
        bf16* XB = (bf16*)(ws + WS_XB); bf16* PB = (bf16*)(ws + WS_PB);
        float* small = (float*)(ws + WS_SMALL);
        float* RSTD0 = (float*)((char*)small + SM_RSTD0); float* SSQ1 = (float*)((char*)small + SM_SSQ1);
        for (int m = gw; m < M; m += NGW) {
            const float* xrow = (m < MP) ? A.in[I_XP] + (size_t)m * D : A.in[I_XS] + (size_t)(m - MP) * D;
            const f32x4* xr = (const f32x4*)xrow + lane; f32x4 v[4]; float s = 0.f;
#pragma unroll
            for (int j = 0; j < 4; ++j) { v[j] = xr[64 * j]; s += (v[j].x * v[j].x + v[j].y * v[j].y) + (v[j].z * v[j].z + v[j].w * v[j].w); }
            s = wave_sum(s);
            v2u* o8 = (v2u*)(XB + (size_t)m * D) + lane;
#pragma unroll
            for (int j = 0; j < 4; ++j) { v2u w; w.x = pk2(v[j].x, v[j].y); w.y = pk2(v[j].z, v[j].w); o8[64 * j] = w; }
            const float* prow = (m < MP) ? A.in[I_PP] + (size_t)m * PD : A.in[I_PS] + (size_t)(m - MP) * PD;
            const f32x4 pv = ((const f32x4*)prow)[lane]; v2u pw; pw.x = pk2(pv.x, pv.y); pw.y = pk2(pv.z, pv.w); ((v2u*)(PB + (size_t)m * PD))[lane] = pw;
            if (lane == 0) { RSTD0[m] = 1.0f / sqrtf(s * (1.0f / D) + EPS); }
            if (lane < 3) SSQ1[lane * M + m] = 0.f;
        }
        if (F.wg == 0) { float* LB = (float*)((char*)small + SM_LB); const int c = F.tid; if (c < 512) { const float a0 = A.in[I_HLB][c], a1 = A.in[I_HLB][512 + c]; LB[c] = 1.0f / (1.0f + expf(a1 - a0)); } }
    } else {
        constexpr int NITEMS = NI_HU + NI_OUT + 2 * NI_G + NI_DN + NI_PG + NI_PP + NI_FOLD;
        for (int it = gw; it < NITEMS; it += NGW) {
            int r = it;
            if (r < NI_HU) { const int kb = r / 32, nb = r % 32; p0_transpose_item(A.in[I_WHUP], D, nullptr, WAB, 1024, 32 * nb, 64 * kb, 32 * nb, 512, scr, lane); continue; } r -= NI_HU;
            if (r < NI_OUT) { const int kb = r / 32, nb = r % 32; p0_transpose_item(A.in[I_WOUT], D, nullptr, WOUT, 1024, 32 * nb, 64 * kb, 32 * nb, 0, scr, lane); continue; } r -= NI_OUT;
            if (r < NI_G) { const int kb = r / 88, nb = r % 88, n0 = 32 * nb; p0_transpose_item(A.in[I_WFG], FF, A.in[I_GFFN], WGU, 1024, (n0 >> 7) * 256 + (n0 & 127), 64 * kb, n0, 0, scr, lane); continue; } r -= NI_G;
            if (r < NI_G) { const int kb = r / 88, nb = r % 88, n0 = 32 * nb; p0_transpose_item(A.in[I_WFU], FF, A.in[I_GFFN], WGU, 1024, (n0 >> 7) * 256 + 128 + (n0 & 127), 64 * kb, n0, 0, scr, lane); continue; } r -= NI_G;
            if (r < NI_DN) { const int kb = r / 32, nb = r % 32; p0_transpose_item(A.in[I_WFD], D, nullptr, WDN, FF, 32 * nb, 64 * kb, 32 * nb, 0, scr, lane); continue; } r -= NI_DN;
            if (r < NI_PG) { const int kb = r / 32, nb = r % 32; p0_transpose_item(A.in[I_WPG], D, A.in[I_GPLE], WPG, 1024, 32 * nb, 64 * kb, 32 * nb, 0, scr, lane); continue; } r -= NI_PG;
            if (r < NI_PP) { const int kb = r / 32, nb = r % 32; p0_transpose_item(A.in[I_WPPJ], D, nullptr, WPP, 256, 32 * nb, 64 * kb, 32 * nb, 0, scr, lane); continue; } r -= NI_PP;
            p0_fold_item(A.in[I_WPMIX], A.in[I_WPUP], A.in[I_PSCALE], WAB, r, lane);
        }
        __syncthreads();
    }
}

__device__ __forceinline__ void p2_pool(const Frame& F, const Args& A, int wg0) {
    const float* U = F.out + OUT_Y; bf16* AB = (bf16*)(F.ws + WS_XB);
    const int gt = (F.wg - wg0) * (NWAVES * 64) + F.tid, NT = (F.G - wg0) * NWAVES * 64;
    constexpr int NBLK = MP / 16 + DB;
    for (int it = gt; it < NBLK * 128; it += NT) {
        const int blk = it >> 7, c = (it & 127) * 4, wsel = c >> 7;
        f32x4 x[31];
        int m0, t0, nt;
        if (blk < MP / 16) {
            m0 = blk * 16; t0 = m0 & (SEQ - 1); nt = 16;
#pragma unroll
            for (int i = 0; i < 31; ++i) x[i] = (i >= 15 || t0 != 0) ? *(const f32x4*)(U + (size_t)(m0 - 15 + i) * PW + c) : (f32x4){0.f, 0.f, 0.f, 0.f};
        } else {
            const int b = blk - MP / 16; m0 = MP + b * DS; t0 = 1 << 20; nt = DS;
#pragma unroll
            for (int i = 0; i < 31; ++i) x[i] = (i < 15) ? *(const f32x4*)(A.in[I_SPOOL] + ((size_t)b * PBUF + i) * PW + c) : (i < 23) ? *(const f32x4*)(U + (size_t)(m0 + i - 15) * PW + c) : (f32x4){0.f, 0.f, 0.f, 0.f};
        }
#pragma unroll
        for (int tt = 0; tt < 16; ++tt) {
            const int i = 15 + tt;
            const f32x4 s2 = x[i] + x[i - 1];
            const f32x4 s4 = s2 + (x[i - 2] + x[i - 3]);
            const f32x4 s8 = s4 + ((x[i - 4] + x[i - 5]) + (x[i - 6] + x[i - 7]));
            const f32x4 s16 = s8 + (((x[i - 8] + x[i - 9]) + (x[i - 10] + x[i - 11])) + ((x[i - 12] + x[i - 13]) + (x[i - 14] + x[i - 15])));
            const f32x4 sw = wsel == 0 ? s2 : wsel == 1 ? s4 : wsel == 2 ? s8 : s16;
            const int w = 2 << wsel, cnt = (t0 + tt + 1 < w) ? t0 + tt + 1 : w;
            const f32x4 pooled = sw * (1.0f / (float)cnt) - x[i];
            if (tt < nt) { v2u o; o.x = pk2(pooled.x, pooled.y); o.y = pk2(pooled.z, pooled.w); *(v2u*)(AB + (size_t)(m0 + tt) * 1024 + c) = o; }
        }
    }
    float* NPP = F.out + OUT_NPP; float* NPS = F.out + OUT_NPS;
    for (int idx = gt; idx < NB * PBUF * PW; idx += NT) { const int c = idx & 511, i = (idx >> 9) % PBUF, b = (idx >> 9) / PBUF; NPP[idx] = U[((size_t)b * SEQ + SEQ - PBUF + i) * PW + c]; }
    for (int idx = gt; idx < DB * PBUF * PW; idx += NT) { const int c = idx & 511, i = (idx >> 9) % PBUF, b = (idx >> 9) / PBUF;
        NPS[idx] = (i < 7) ? A.in[I_SPOOL][((size_t)b * PBUF + 8 + i) * PW + c] : U[((size_t)MP + b * DS + (i - 7)) * PW + c]; }
}

__device__ __forceinline__ void p2_rec_sample(const Frame& F, const Args& A, int item) {
    const float* FG = F.out + OUT_Y + (size_t)M * PW; const bf16* QB = (const bf16*)(F.ws + WS_QB); const bf16* VB = (const bf16*)(F.ws + WS_VB); const bf16* SG = (const bf16*)(F.ws + WS_SG); bf16* AB = (bf16*)(F.ws + WS_XB);
    LAS float* Fs = (LAS float*)(F.lds); LAS float* Qs = Fs + DS * 128; LAS float* Vs = Qs + DS * 128; LAS float* Os = Vs + DS * 128;
    const int tid = F.tid, vi = tid >> 2, kg = tid & 3;
    const int b = item >> 2, h = item & 3, row0 = MP + b * DS;
    const float* s0 = A.in[I_SHGRN] + (size_t)item * DK * DV; float* sout = F.out + OUT_NHS + (size_t)item * DK * DV;
    float S[32];
#pragma unroll
    for (int i = 0; i < 32; ++i) S[i] = s0[(size_t)(kg * 32 + i) * DV + vi];
    for (int idx = tid; idx < DS * 128; idx += 512) { const int tt = idx >> 7, c = idx & 127; const size_t g = (size_t)(row0 + tt) * HW + h * 128 + c; Fs[idx] = FG[g]; Qs[idx] = bf2f(QB[g]); Vs[idx] = bf2f(VB[g]); }
    __syncthreads();
#pragma unroll 1
    for (int tt = 0; tt < DS; ++tt) {
        const float v = Vs[tt * 128 + vi]; float a = 0.f;
        const LAS f32x4* fp = (const LAS f32x4*)(Fs + tt * 128 + kg * 32); const LAS f32x4* qp = (const LAS f32x4*)(Qs + tt * 128 + kg * 32);
#pragma unroll
        for (int i4 = 0; i4 < 8; ++i4) { const f32x4 f = fp[i4], q = qp[i4];
#pragma unroll
            for (int e = 0; e < 4; ++e) { const int i = i4 * 4 + e; S[i] = f[e] * S[i] + (1.0f - f[e]) * v; a += S[i] * q[e]; } }
        a += __shfl_xor(a, 1); a += __shfl_xor(a, 2);
        if (kg == 0) Os[tt * 128 + vi] = a;
    }
#pragma unroll
    for (int i = 0; i < 32; ++i) sout[(size_t)(kg * 32 + i) * DV + vi] = S[i];
    __syncthreads();
    {
        const int t = tid >> 6, c = 2 * (tid & 63); const float o0 = Os[t * 128 + c], o1 = Os[t * 128 + c + 1];
        const float ss = wave_sum(o0 * o0 + o1 * o1); const float r = 1.0f / sqrtf(ss * (1.0f / DV) + EPS);
        const size_t g = (size_t)(row0 + t) * HW + h * 128 + c; const unsigned sgw = *(const unsigned*)(SG + g);
        const float n0 = A.in[I_HNORM][h * 128 + c], n1 = A.in[I_HNORM][h * 128 + c + 1];
        *(unsigned*)(AB + (size_t)(row0 + t) * 1024 + 512 + h * 128 + c) = pk2(o0 * r * n0 * pg8::bf_lo(sgw), o1 * r * n1 * pg8::bf_hi(sgw));
    }
    __syncthreads();
}

constexpr int RQ_RS = 288, RK_RS = 160;
constexpr int L_QE = 0, L_KE = L_QE + 64 * RQ_RS, L_KDT = L_KE + 64 * RQ_RS, L_VT = L_KDT + 128 * RK_RS, L_DEC = L_VT + 128 * RK_RS, L_O = L_DEC + 512, O_RS = 132 * 4, L_END = L_O + 64 * O_RS;
static_assert(L_END <= RING_BYTES, "recurrence LDS map");
typedef short bf16x8v __attribute__((ext_vector_type(8)));
__device__ __forceinline__ void p2_rec_prompt(const Frame& F, const Args& A, int seq) {
    using pg8::cvt_pk_bf16;
    const bf16* QE = (const bf16*)(F.ws + WS_QB); const bf16* KE = (const bf16*)(F.ws + WS_KE); const bf16* SG = (const bf16*)(F.ws + WS_SG); bf16* AB = (bf16*)(F.ws + WS_XB);
    const bf16* KDT = (const bf16*)(F.ws + WS_KDT); const bf16* VT = (const bf16*)(F.out + OUT_Y + (size_t)M * PW); const float* DEC = (const float*)((const char*)(F.out + OUT_Y + (size_t)M * PW) + 16 * MiB);
    LAS unsigned char* lds = F.lds;
    const int tid = F.tid, lane = F.lane, w = F.wave, idx = lane & 15, g = lane >> 4;
    const int b = seq >> 2, h = seq & 3, row0 = b * SEQ, chunk0 = b * (SEQ / 64);
    unsigned gq[2], lq[2], gk[2], lk[2];
#pragma unroll
    for (int j = 0; j < 2; ++j) {
        const int q = tid + 512 * j;
        { const int row = q >> 4, c16 = q & 15, kb = c16 >> 2, c = c16 & 3; gq[j] = (unsigned)(row * 512 + c16 * 8) * 2u; lq[j] = (unsigned)(row * RQ_RS + kb * 64 + (16 * (c & 1) + 4 * (c >> 1)) * 2); }
        { const int row = q >> 3, c8 = q & 7, sb = c8 >> 2, c = c8 & 3; gk[j] = (unsigned)(row * 64 + c8 * 8) * 2u; lk[j] = (unsigned)(row * RK_RS + sb * 64 + (16 * (c & 1) + 4 * (c >> 1)) * 2); }
    }
    v4u pf[8]; f32x4 pfd;
#define REC_LOAD(n_) do { const size_t rb = (size_t)(row0 + 64 * (n_)) * 512 + h * 128; const size_t cb = ((size_t)(chunk0 + (n_)) * 512 + h * 128) * 64; \
        _Pragma("unroll") for (int j = 0; j < 2; ++j) { pf[j] = *(const v4u*)((const char*)(QE + rb) + gq[j]); pf[2 + j] = *(const v4u*)((const char*)(KE + rb) + gq[j]); \
            pf[4 + j] = *(const v4u*)((const char*)(KDT + cb) + gk[j]); pf[6 + j] = *(const v4u*)((const char*)(VT + cb) + gk[j]); } \
        if (tid < 32) pfd = *(const f32x4*)(DEC + (size_t)(chunk0 + (n_)) * 512 + h * 128 + tid * 4); } while (0)
#define REC_STORE() do { _Pragma("unroll") for (int j = 0; j < 2; ++j) { \
            *(LAS v2u*)(lds + L_QE + lq[j]) = (v2u){pf[j].x, pf[j].y}; *(LAS v2u*)(lds + L_QE + lq[j] + 16) = (v2u){pf[j].z, pf[j].w}; \
            *(LAS v2u*)(lds + L_KE + lq[j]) = (v2u){pf[2 + j].x, pf[2 + j].y}; *(LAS v2u*)(lds + L_KE + lq[j] + 16) = (v2u){pf[2 + j].z, pf[2 + j].w}; \
            *(LAS v2u*)(lds + L_KDT + lk[j]) = (v2u){pf[4 + j].x, pf[4 + j].y}; *(LAS v2u*)(lds + L_KDT + lk[j] + 16) = (v2u){pf[4 + j].z, pf[4 + j].w}; \
            *(LAS v2u*)(lds + L_VT + lk[j]) = (v2u){pf[6 + j].x, pf[6 + j].y}; *(LAS v2u*)(lds + L_VT + lk[j] + 16) = (v2u){pf[6 + j].z, pf[6 + j].w}; } \
        if (tid < 32) *(LAS f32x4*)(lds + L_DEC + tid * 16) = pfd; } while (0)
    f32x4 S[8];
#pragma unroll
    for (int kt = 0; kt < 8; ++kt) S[kt] = (f32x4){0.f, 0.f, 0.f, 0.f};
    const unsigned fq_ = (unsigned)(L_QE + idx * RQ_RS + g * 16), fk_ = (unsigned)(L_KE + idx * RQ_RS + g * 16), fd_ = (unsigned)(L_KDT + idx * RK_RS + g * 16), fv_ = (unsigned)(L_VT + (16 * w + idx) * RK_RS + g * 16);
    const int et = tid >> 3, evq = tid & 7;
    f32x4 hn[4];
#pragma unroll
    for (int i = 0; i < 4; ++i) hn[i] = *(const f32x4*)(A.in[I_HNORM] + h * 128 + 16 * evq + 4 * i);
    REC_LOAD(0); REC_STORE(); __syncthreads();
#pragma unroll 1
    for (int n = 0; n < SEQ / 64; ++n) {
        if (n + 1 < SEQ / 64) REC_LOAD(n + 1);
        const size_t erow = (size_t)(row0 + 64 * n + et);
        const v4u sg0 = *(const v4u*)(SG + erow * HW + h * 128 + 16 * evq), sg1 = *(const v4u*)(SG + erow * HW + h * 128 + 16 * evq + 8);
        f32x4 at[4][4], o[4]; bf16x8v vt[2];
#pragma unroll
        for (int tt = 0; tt < 4; ++tt) { o[tt] = (f32x4){0.f, 0.f, 0.f, 0.f};
#pragma unroll
            for (int st = 0; st < 4; ++st) at[tt][st] = (f32x4){0.f, 0.f, 0.f, 0.f}; }
#pragma unroll
        for (int sb = 0; sb < 2; ++sb) vt[sb] = *(const LAS bf16x8v*)(lds + fv_ + sb * 64);
#pragma unroll
        for (int kb = 0; kb < 4; ++kb) {
            bf16x8v qf[4], kf[4];
#pragma unroll
            for (int t4 = 0; t4 < 4; ++t4) { qf[t4] = *(const LAS bf16x8v*)(lds + fq_ + t4 * 16 * RQ_RS + kb * 64); kf[t4] = *(const LAS bf16x8v*)(lds + fk_ + t4 * 16 * RQ_RS + kb * 64); }
            union { bf16x8v v; unsigned u[4]; } sb_;
            sb_.u[0] = cvt_pk_bf16(S[2 * kb][0], S[2 * kb][1]); sb_.u[1] = cvt_pk_bf16(S[2 * kb][2], S[2 * kb][3]); sb_.u[2] = cvt_pk_bf16(S[2 * kb + 1][0], S[2 * kb + 1][1]); sb_.u[3] = cvt_pk_bf16(S[2 * kb + 1][2], S[2 * kb + 1][3]);
#pragma unroll
            for (int tt = 0; tt < 4; ++tt) {
                o[tt] = __builtin_amdgcn_mfma_f32_16x16x32_bf16(qf[tt], sb_.v, o[tt], 0, 0, 0);
#pragma unroll
                for (int st = 0; st < 4; ++st) if (st <= tt) at[tt][st] = __builtin_amdgcn_mfma_f32_16x16x32_bf16(kf[st], qf[tt], at[tt][st], 0, 0, 0);
            }
        }
#pragma unroll
        for (int tt = 0; tt < 4; ++tt) {
#pragma unroll
            for (int r = 0; r < 4; ++r) if (4 * g + r > idx) at[tt][tt][r] = 0.f;
#pragma unroll
            for (int sb = 0; sb < 2; ++sb) if (2 * sb <= tt) {
                union { bf16x8v v; unsigned u[4]; } ab;
                ab.u[0] = cvt_pk_bf16(at[tt][2 * sb][0], at[tt][2 * sb][1]); ab.u[1] = cvt_pk_bf16(at[tt][2 * sb][2], at[tt][2 * sb][3]);
                if (2 * sb + 1 <= tt) { ab.u[2] = cvt_pk_bf16(at[tt][2 * sb + 1][0], at[tt][2 * sb + 1][1]); ab.u[3] = cvt_pk_bf16(at[tt][2 * sb + 1][2], at[tt][2 * sb + 1][3]); } else { ab.u[2] = 0u; ab.u[3] = 0u; }
                o[tt] = __builtin_amdgcn_mfma_f32_16x16x32_bf16(ab.v, vt[sb], o[tt], 0, 0, 0);
            }
        }
#pragma unroll
        for (int kt = 0; kt < 8; ++kt) {
            const f32x4 dc = *(const LAS f32x4*)(lds + L_DEC + (16 * kt + 4 * g) * 4);
            f32x4 s_ = S[kt] * dc;
#pragma unroll
            for (int sb = 0; sb < 2; ++sb) s_ = __builtin_amdgcn_mfma_f32_16x16x32_bf16(*(const LAS bf16x8v*)(lds + fd_ + kt * 16 * RK_RS + sb * 64), vt[sb], s_, 0, 0, 0);
            S[kt] = s_;
        }
#pragma unroll
        for (int tt = 0; tt < 4; ++tt)
#pragma unroll
            for (int r = 0; r < 4; ++r) *(LAS float*)(lds + L_O + (16 * tt + 4 * g + r) * O_RS + (16 * w + idx) * 4) = o[tt][r];
        __syncthreads();
        {
            f32x4 ov[4]; float ss = 0.f;
#pragma unroll
            for (int i = 0; i < 4; ++i) { ov[i] = *(const LAS f32x4*)(lds + L_O + et * O_RS + (16 * evq + 4 * i) * 4); ss += (ov[i][0] * ov[i][0] + ov[i][1] * ov[i][1]) + (ov[i][2] * ov[i][2] + ov[i][3] * ov[i][3]); }
            ss += __shfl_xor(ss, 1); ss += __shfl_xor(ss, 2); ss += __shfl_xor(ss, 4);
            const float r = 1.0f / sqrtf(ss * (1.0f / DV) + EPS);
            f32x4 g0, g1, g2, g3; pg8::unpack8(sg0, g0, g1); pg8::unpack8(sg1, g2, g3);
            bf16* dst = AB + erow * 1024 + 512 + h * 128 + 16 * evq;
            *(v4u*)dst = pg8::pack8(ov[0] * r * hn[0] * g0, ov[1] * r * hn[1] * g1); *(v4u*)(dst + 8) = pg8::pack8(ov[2] * r * hn[2] * g2, ov[3] * r * hn[3] * g3);
        }
        if (n + 1 < SEQ / 64) REC_STORE();
        __syncthreads();
    }
    float* sout = F.out + OUT_NHP + (size_t)seq * DK * DV;
#pragma unroll
    for (int kt = 0; kt < 8; ++kt)
#pragma unroll
        for (int r = 0; r < 4; ++r) sout[(size_t)(16 * kt + 4 * g + r) * DV + 16 * w + idx] = S[kt][r];
#undef REC_LOAD
#undef REC_STORE
}
__device__ __forceinline__ void p_final(const Frame& F, const Args& A) {
    float* Y = F.out + OUT_Y; const float* SSQ3 = (const float*)(F.ws + WS_SMALL + SM_SSQ3);
    const int gw = F.wg * NWAVES + F.wave, NGW = F.G * NWAVES, lane = F.lane;
    f32x4 gf[4];
#pragma unroll
    for (int j = 0; j < 4; ++j) gf[j] = ((const f32x4*)A.in[I_GFIN])[lane + 64 * j];
    for (int m = gw; m < M; m += NGW) {
        const float r = 1.0f / sqrtf(SSQ3[m] * (1.0f / D) + EPS);
        f32x4* yr = (f32x4*)(Y + (size_t)m * D) + lane;
#pragma unroll
        for (int j = 0; j < 4; ++j) yr[64 * j] = yr[64 * j] * r * gf[j];
    }
}

#ifndef MK_N_LAUNCHES
#define MK_N_LAUNCHES 1
#endif
constexpr int N_PHASES = 12;
#ifndef PROG
#define PROG 0xff7ull
#endif

__global__ void __launch_bounds__(NWAVES * 64, 2) fwd_kernel(Args args) {
    extern __shared__ __attribute__((aligned(16))) unsigned char lds_raw[];
    Frame F;
    F.lds = (LAS unsigned char*)lds_raw;
    F.tid = threadIdx.x; F.lane = F.tid & 63; F.wave = __builtin_amdgcn_readfirstlane(F.tid >> 6);
    F.G = gridDim.x; F.wg = blockIdx.x;
    F.out = args.out; F.ws = args.ws;
    unsigned char* ws = args.ws;
    using namespace pg8;
    float* small = (float*)(ws + WS_SMALL);
    float* LB = (float*)((char*)small + SM_LB); float* RSTD0 = (float*)((char*)small + SM_RSTD0);
    float* SSQ1 = (float*)((char*)small + SM_SSQ1); float* SSQ2 = (float*)((char*)small + SM_SSQ2); float* SSQ3 = (float*)((char*)small + SM_SSQ3);
    bf16_t *WIN = (bf16_t*)(ws + WS_WIN), *WAB = (bf16_t*)(ws + WS_WAB), *WOUT = (bf16_t*)(ws + WS_WOUT), *WGU = (bf16_t*)(ws + WS_WGU), *WDN = (bf16_t*)(ws + WS_WDN), *WPG = (bf16_t*)(ws + WS_WPG), *WPP = (bf16_t*)(ws + WS_WPP);
    bf16_t *PB = (bf16_t*)(ws + WS_PB), *XB = (bf16_t*)(ws + WS_XB), *QB = (bf16_t*)(ws + WS_QB), *VB = (bf16_t*)(ws + WS_VB), *SG = (bf16_t*)(ws + WS_SG), *GA = (bf16_t*)(ws + WS_GA), *GB = (bf16_t*)(ws + WS_GB);
    bf16_t *MG = (bf16_t*)(ws + WS_O), *EMB = (bf16_t*)(ws + WS_O), *ACT = (bf16_t*)(ws + WS_ACT);
    float* Y = F.out + OUT_Y; float* U = Y; float* FGp = Y + (size_t)M * PW; float* T = Y;
    const int c = (int)blockIdx.x;

#define IN(k) ((pmask >> (k)) & 1u)
#define SEAM(k) do { if (IN(k) && (pmask >> ((k) + 1))) { xcd_barrier(bar); } } while (0)
#ifndef PROBE_DUP
#define PROBE_DUP 0x0
#endif
#define DUP(k) ((PROBE_DUP >> (k)) & 1)
    const unsigned pmask = (unsigned)args.prog;
    for (int u = F.tid; u < (LDS_BYTES - MISC_OFF) / 4; u += NWAVES * 64) ((LAS unsigned*)(F.lds + MISC_OFF))[u] = 0u;
    __syncthreads();
    XcdBarrier bar = xcd_barrier_post((unsigned*)(ws + WS_CTL), (volatile LAS unsigned*)(F.lds + MISC_OFF) + 8);
    if (pmask & 0x80000000u) cg::this_grid().sync();
#define PH0 { p0_prologue<0>(F, args, 0); }
#define PH1 { Gemm g{XB, WIN, M, NIN, D, D, D}; StaticOrder S; S.init(M, NIN, F.G, c); EpiIn E{U, QB, (bf16_t*)(ws + WS_KE), (bf16_t*)(ws + WS_KDT), (float*)((char*)FGp + 16 * MiB), FGp, VB, (bf16_t*)FGp, SG, GA, GB, RSTD0, LB}; gemm_phase<EpiIn, StaticOrder, true>(F.lds, g, S, E); }
#define PH2 { if (F.wg < 32) p2_rec_prompt(F, args, F.wg); else { p0_prologue<1>(F, args, 32); p2_pool(F, args, 32); for (int it = F.wg - 32; it < 512; it += F.G - 32) p2_rec_sample(F, args, it); } }
#define PH3 { }
#define PH4 { Gemm g{XB, WAB, M, D, 512, D, D}; StaticOrder S; S.init(M, D, F.G, c); EpiGateA E{T, GA}; gemm_phase<EpiGateA, StaticOrder, true>(F.lds, g, S, E); }
#define PH5 { Gemm g{XB + 512, WAB + 512, M, D, 512, D, D}; StaticOrder S; S.init(M, D, F.G, c); EpiGateB E{T, GB, MG}; gemm_phase<EpiGateB, StaticOrder, true>(F.lds, g, S, E); }
#define PH6 { Gemm g{MG, WOUT, M, D, D, D, D}; StaticOrder S; S.init(M, D, F.G, c); EpiRes E{args.in[I_XP], args.in[I_XS] - (size_t)MP * D, Y, XB, SSQ1}; gemm_phase<EpiRes, StaticOrder, true>(F.lds, g, S, E); }
#define PH7 { Gemm g{XB, WGU, M, 2 * FF, D, D, D}; StaticOrder S; S.init(M, 2 * FF, F.G, c); EpiSwiGLU E{ACT, SSQ1}; gemm_phase<EpiSwiGLU, StaticOrder, true>(F.lds, g, S, E); }
#define PH8 { Gemm g{ACT, WDN, M, D, FF, FF, FF}; StaticOrder S; S.init(M, D, F.G, c); EpiRes E{Y, Y, Y, XB, SSQ2}; gemm_phase<EpiRes, StaticOrder, true>(F.lds, g, S, E); }
#define PH9 { Gemm g{PB, WPP, M, D, PD, PD, PD}; StaticOrder S; S.init(M, D, F.G, c); EpiBf E{EMB}; gemm_phase<EpiBf, StaticOrder, true>(F.lds, g, S, E); }
#define PH10 { Gemm g{XB, WPG, M, D, D, D, D}; StaticOrder S; S.init(M, D, F.G, c); EpiPle E{Y, EMB, SSQ2, SSQ3}; gemm_phase<EpiPle, StaticOrder, true>(F.lds, g, S, E); }
#define PH11 { p_final(F, args); }
#define RUN(k, BODY) if (IN(k)) { BODY if (DUP(k)) { xcd_barrier(bar); BODY } } SEAM(k);
    RUN(0, PH0) RUN(1, PH1) RUN(2, PH2) RUN(3, PH3) RUN(4, PH4) RUN(5, PH5) RUN(6, PH6) RUN(7, PH7) RUN(8, PH8) RUN(9, PH9) RUN(10, PH10) RUN(11, PH11)
}

extern "C" void kernel_launch(void* const* d_in, const int* in_sizes, int n_in, void* d_out, int out_size, void* d_ws, size_t ws_size, hipStream_t stream) {
    static int grid = 0;
    if (grid == 0) {
        if (n_in != 23 || in_sizes[0] != MP * D || (size_t)out_size != OUT_END || ws_size < WS_END) { fprintf(stderr, "kernel_launch: unexpected shapes (n_in %d, in0 %d, out %d, ws %zu)\n", n_in, n_in > 0 ? in_sizes[0] : -1, out_size, ws_size); grid = -1; return; }
        int dev = 0, cus = 0, per_cu = 0;
        if (hipGetDevice(&dev) != hipSuccess || hipDeviceGetAttribute(&cus, hipDeviceAttributeMultiprocessorCount, dev) != hipSuccess) { grid = -1; return; }
        if (hipFuncSetAttribute((const void*)fwd_kernel, hipFuncAttributeMaxDynamicSharedMemorySize, LDS_BYTES) != hipSuccess) { fprintf(stderr, "kernel_launch: hipFuncSetAttribute failed\n"); grid = -1; return; }
        if (hipOccupancyMaxActiveBlocksPerMultiprocessor(&per_cu, (const void*)fwd_kernel, NWAVES * 64, LDS_BYTES) != hipSuccess || per_cu < 1) { fprintf(stderr, "kernel_launch: occupancy query says %d blocks per CU\n", per_cu); (void)hipGetLastError(); grid = -1; return; }
        grid = cus * per_cu;
    }
    if (grid < 0) return;
    (void)hipMemsetAsync((char*)d_ws + WS_CTL, 0, 65536, stream);
    Args a{};
    for (int i = 0; i < 23; ++i) a.in[i] = (const float*)d_in[i];
    a.out = (float*)d_out; a.ws = (unsigned char*)d_ws;
#if MK_N_LAUNCHES == 1
    a.prog = PROG;
    void* kargs[] = {&a};
    hipError_t e = hipLaunchCooperativeKernel((const void*)fwd_kernel, dim3(grid), dim3(NWAVES * 64), kargs, LDS_BYTES, stream);
    if (e != hipSuccess) fprintf(stderr, "cooperative launch failed: %s (grid %d)\n", hipGetErrorString(e), grid);
#else
#error multi-launch build removed
#endif
}
```
